# Optimizing an MI355X kernel written in HIP

```python
import math
import jax, jax.numpy as jnp
from jax import lax
import numpy as np

D_MODEL = 1024
BATCH = 2
SEQ = 8192
DEPTH = 1

POOL_WIDTH = D_MODEL // 2
POOL_WINDOWS = (2, 4, 8, 16)
N_POOL_GROUPS = len(POOL_WINDOWS)
POOL_GROUP = POOL_WIDTH // N_POOL_GROUPS
ATTN_WIDTH = D_MODEL // 2
N_HEADS = 4
HEAD_DIM = ATTN_WIDTH // (2 * N_HEADS)
V_DIM = 2 * HEAD_DIM
Q_BLOCK = 128
N_BRANCHES = 2
D_FF = 4 * D_MODEL
IN_WIDTH = POOL_WIDTH + 2 * ATTN_WIDTH + N_HEADS * V_DIM + N_BRANCHES * D_MODEL
EPS = 1e-6

kernel_name = "hybrid_pool_diffattn_gated_block"


def _alibi_slopes(n_heads):
    return jnp.asarray(np.array([2.0 ** (-8.0 * (h + 1) / n_heads) for h in range(n_heads)], dtype=np.float32))


def _lambda_init(layer_idx):
    return 0.8 - 0.6 * math.exp(-0.3 * layer_idx)


def rmsnorm(x, g):
    xf = x.astype(jnp.float32)
    y = xf * lax.rsqrt(jnp.mean(xf * xf, axis=-1, keepdims=True) + EPS)
    return (y * g.astype(jnp.float32)).astype(x.dtype)


def causal_multiscale_pool(u, pool_w, pool_scale):
    B, S, _ = u.shape
    ug = u.reshape(B, S, N_POOL_GROUPS, POOL_GROUP).astype(jnp.float32)
    cs = jnp.cumsum(ug, axis=1)
    cs = jnp.concatenate([jnp.zeros((B, 1, N_POOL_GROUPS, POOL_GROUP), jnp.float32), cs], axis=1)
    t = jnp.arange(S)
    means = []
    for g, w in enumerate(POOL_WINDOWS):
        lo = jnp.maximum(t + 1 - w, 0)
        cnt = (t + 1 - lo).astype(jnp.float32)
        means.append((cs[:, 1:, g] - cs[:, lo, g]) / cnt[None, :, None])
    pooled = jnp.stack(means, axis=2) - ug
    mixed = jnp.einsum('bsgc,gcd->bsgd', pooled.astype(u.dtype), pool_w)
    return mixed.reshape(B, S, POOL_WIDTH) * pool_scale


def differential_attention(q, k, v, lam, lambda_init, subln_g):
    B, S = q.shape[0], q.shape[1]
    nb = S // Q_BLOCK
    scale = 1.0 / math.sqrt(HEAD_DIM)
    slopes = _alibi_slopes(N_HEADS)
    kpos = jnp.arange(S)
    qb = q.reshape(B, nb, Q_BLOCK, N_HEADS, 2, HEAD_DIM).transpose(1, 0, 2, 3, 4, 5)

    def one_block(args):
        qi, bi = args
        qpos = bi * Q_BLOCK + jnp.arange(Q_BLOCK)
        s = jnp.einsum('bqhcd,bkhcd->bhcqk', qi, k, preferred_element_type=jnp.float32) * scale
        dist = (qpos[:, None] - kpos[None, :]).astype(jnp.float32)
        s = s - slopes[:, None, None, None] * dist[None, None]
        causal = kpos[None, :] <= qpos[:, None]
        s = jnp.where(causal[None, None, None], s, -jnp.inf)
        p = jax.nn.softmax(s, axis=-1)
        a = p[:, :, 0] - lam * p[:, :, 1]
        return jnp.einsum('bhqk,bkhv->bqhv', a.astype(v.dtype), v)

    o = lax.map(one_block, (qb, jnp.arange(nb)))
    o = o.transpose(1, 0, 2, 3, 4).reshape(B, S, N_HEADS, V_DIM)
    o = rmsnorm(o, subln_g) * (1.0 - lambda_init)
    return o.reshape(B, S, N_HEADS * V_DIM)


def setup_inputs(seed: int = 0) -> dict:
    key = jax.random.key(seed)
    ks = jax.random.split(key, 20)
    f32 = jnp.float32
    nrm = lambda k, shape, s: (jax.random.normal(k, shape, f32) * s).astype(f32)
    return {
        "x": nrm(ks[0], (BATCH, SEQ, D_MODEL), 1.0),
        "norm1_g": 1.0 + nrm(ks[1], (DEPTH, D_MODEL), 0.05),
        "w_in": nrm(ks[2], (DEPTH, D_MODEL, IN_WIDTH), D_MODEL ** -0.5),
        "gate_b": nrm(ks[3], (DEPTH, N_BRANCHES * D_MODEL), 0.02),
        "pool_w": nrm(ks[4], (DEPTH, N_POOL_GROUPS, POOL_GROUP, POOL_GROUP), POOL_GROUP ** -0.5),
        "pool_scale": 1.0 + nrm(ks[5], (DEPTH, POOL_WIDTH), 0.05),
        "q_norm_g": 1.0 + nrm(ks[6], (DEPTH, HEAD_DIM), 0.05),
        "k_norm_g": 1.0 + nrm(ks[7], (DEPTH, HEAD_DIM), 0.05),
        "lambda_q1": nrm(ks[8], (DEPTH, HEAD_DIM), 0.1),
        "lambda_k1": nrm(ks[9], (DEPTH, HEAD_DIM), 0.1),
        "lambda_q2": nrm(ks[10], (DEPTH, HEAD_DIM), 0.1),
        "lambda_k2": nrm(ks[11], (DEPTH, HEAD_DIM), 0.1),
        "subln_g": 1.0 + nrm(ks[12], (DEPTH, V_DIM), 0.05),
        "w_branch_a": nrm(ks[13], (DEPTH, POOL_WIDTH, D_MODEL), POOL_WIDTH ** -0.5),
        "w_branch_b": nrm(ks[14], (DEPTH, N_HEADS * V_DIM, D_MODEL), (N_HEADS * V_DIM) ** -0.5),
        "w_out": nrm(ks[15], (DEPTH, D_MODEL, D_MODEL), D_MODEL ** -0.5),
        "norm2_g": 1.0 + nrm(ks[16], (DEPTH, D_MODEL), 0.05),
        "w_ff1": nrm(ks[17], (DEPTH, D_MODEL, D_FF), D_MODEL ** -0.5),
        "w_ff2": nrm(ks[18], (DEPTH, D_FF, D_MODEL), D_FF ** -0.5),
    }


def reference(x, norm1_g, w_in, gate_b, pool_w, pool_scale, q_norm_g, k_norm_g,
              lambda_q1, lambda_k1, lambda_q2, lambda_k2, subln_g,
              w_branch_a, w_branch_b, w_out, norm2_g, w_ff1, w_ff2):
    B, S, D = x.shape
    splits = np.cumsum([POOL_WIDTH, ATTN_WIDTH, ATTN_WIDTH, N_HEADS * V_DIM]).tolist()
    for l in range(DEPTH):
        lambda_init = _lambda_init(l)
        h = rmsnorm(x, norm1_g[l])
        proj = h @ w_in[l]
        u, q, k, v, gl = jnp.split(proj, splits, axis=-1)
        ya = causal_multiscale_pool(u, pool_w[l], pool_scale[l]) @ w_branch_a[l]
        q = rmsnorm(q.reshape(B, S, N_HEADS, 2, HEAD_DIM), q_norm_g[l])
        k = rmsnorm(k.reshape(B, S, N_HEADS, 2, HEAD_DIM), k_norm_g[l])
        v = v.reshape(B, S, N_HEADS, V_DIM)
        lq1k1 = jnp.sum(lambda_q1[l].astype(jnp.float32) * lambda_k1[l].astype(jnp.float32))
        lq2k2 = jnp.sum(lambda_q2[l].astype(jnp.float32) * lambda_k2[l].astype(jnp.float32))
        lam = jnp.exp(lq1k1) - jnp.exp(lq2k2) + lambda_init
        yb = differential_attention(q, k, v, lam, lambda_init, subln_g[l]) @ w_branch_b[l]
        g = jax.nn.sigmoid((gl + gate_b[l]).astype(jnp.float32)).astype(x.dtype)
        g = g.reshape(B, S, N_BRANCHES, D)
        merged = g[:, :, 0] * ya + g[:, :, 1] * yb
        x = x + merged @ w_out[l]
        h2 = rmsnorm(x, norm2_g[l])
        x = x + jnp.square(jax.nn.relu(h2 @ w_ff1[l])) @ w_ff2[l]
    return x
```

```cpp
#include <hip/hip_runtime.h>
#include <hip/hip_cooperative_groups.h>
#include <cstdio>
#include <cstdint>
#include <hip/hip_bf16.h>
#include <cmath>
namespace pg8 {
#define PG8_LAS __attribute__((address_space(3)))
typedef unsigned short bf16_t;
typedef short bf16x8 __attribute__((ext_vector_type(8)));
typedef float f32x4 __attribute__((ext_vector_type(4)));
typedef unsigned u32x4 __attribute__((ext_vector_type(4)));
constexpr int BM = 256, BK = 64, HALF = 128, HTB = HALF * BK * 2  , STAGE_BYTES = 8 * HTB, NXCD = 8, WGM = 8;

__host__ __device__ __forceinline__ int lds_byte(int r, int c) { const int st = (r >> 4) * 2 + (c >> 5), rr = r & 15, cc = c & 31, ob = rr * 64 + cc * 2; return st * 1024 + (ob ^ (((ob >> 9) & 1) << 5)); }
__host__ __device__ __forceinline__ void stage_rc(int b, int& R, int& C) { const int st = b / 1024, sb = b % 1024, swz = sb ^ (((sb >> 9) & 1) << 5); R = (st >> 1) * 16 + swz / 64; C = (st & 1) * 32 + (swz % 64) / 2; }
__host__ __device__ __forceinline__ int perm32(int rho) { const int n = rho >> 4, i = rho & 15; return 8 * (i >> 2) + 4 * n + (i & 3); }

struct Unit { int pm, pn; };
struct Gemm { const bf16_t* A; const bf16_t* Bt; int M, N, K; };

struct StaticOrder {
    int nM, nN, nwg, G, c;
    __host__ __device__ void init(int M, int N, int G_, int c_) { nM = M / BM; nN = N / BM; nwg = nM * nN; G = G_; c = c_; }
    __host__ __device__ bool next(int i, Unit& u) const {
        const long L = (long)i * G + c; if (L >= nwg) return false;
        int wgid = (int)L; { const int q = nwg / NXCD, r = nwg % NXCD, xcd = wgid % NXCD, off = wgid / NXCD; wgid = (xcd < r ? xcd * (q + 1) : r * (q + 1) + (xcd - r) * q) + off; }
        const int nig = WGM * nN, gid = wgid / nig, fm = gid * WGM, gsz = (nM - fm) < WGM ? (nM - fm) : WGM;
        u.pm = fm + ((wgid % nig) % gsz); u.pn = (wgid % nig) / gsz; return true;
    }
    __device__ __forceinline__ void a_ready(const Unit&) const {}
    __device__ __forceinline__ void done(const Unit&) const {}
};

typedef float cvt_f32x2_t __attribute__((ext_vector_type(2))); typedef __bf16 cvt_bf16x2_t __attribute__((ext_vector_type(2)));
__device__ __forceinline__ unsigned cvt_pk_bf16(float lo, float hi) { cvt_f32x2_t v = {lo, hi}; cvt_bf16x2_t b = __builtin_convertvector(v, cvt_bf16x2_t); return __builtin_bit_cast(unsigned, b); }
typedef float f32x2 __attribute__((ext_vector_type(2)));
__device__ __forceinline__ u32x4 pack8(const f32x4 a, const f32x4 b) { u32x4 w; w.x = cvt_pk_bf16(a[0], a[1]); w.y = cvt_pk_bf16(a[2], a[3]); w.z = cvt_pk_bf16(b[0], b[1]); w.w = cvt_pk_bf16(b[2], b[3]); return w; }
__device__ __forceinline__ void unpack8(const u32x4 w, f32x4& a, f32x4& b) {
    a[0] = __uint_as_float(w.x << 16); a[1] = __uint_as_float(w.x & 0xffff0000u); a[2] = __uint_as_float(w.y << 16); a[3] = __uint_as_float(w.y & 0xffff0000u);
    b[0] = __uint_as_float(w.z << 16); b[1] = __uint_as_float(w.z & 0xffff0000u); b[2] = __uint_as_float(w.w << 16); b[3] = __uint_as_float(w.w & 0xffff0000u); }
__device__ __forceinline__ float dot4(const f32x4 x) { return (x[0] * x[0] + x[1] * x[1]) + (x[2] * x[2] + x[3] * x[3]); }
__device__ __forceinline__ f32x4 sigmoid4(const f32x4 x) { f32x4 o;
#pragma unroll
    for (int e = 0; e < 4; ++e) o[e] = __builtin_amdgcn_rcpf(1.0f + __builtin_amdgcn_exp2f(x[e] * -1.4426950408889634f));
    return o; }
constexpr float QK_C2 = 0.125f * 1.4426950408889634f;
struct EpiIn {
    static constexpr bool PERM = true, AFTER_DRAIN = false, HOOK = false, INIT = false;
    bf16_t *U, *Q, *K, *V, *G; const float *qg, *kg, *gb;
    __device__ __forceinline__ void operator()(const f32x4 (&acc)[2][2][4][2], const Unit& u, int wr, int wc, int fr, int fq) const {
        const int pn = u.pn, row0 = u.pm * BM + wr * 64 + fr, cw = 64 * wc + 8 * fq;
        if (pn < 2 || pn == 6 || pn == 7) {
            bf16_t* base = (pn < 2) ? (U + pn * 256) : (V + (pn - 6) * 256);
#pragma unroll
            for (int ai = 0; ai < 2; ++ai)
#pragma unroll
                for (int m = 0; m < 4; ++m) { bf16_t* rowp = base + (size_t)(row0 + ai * HALF + m * 16) * 512 + cw;
#pragma unroll
                    for (int bj = 0; bj < 2; ++bj) *(u32x4*)(rowp + 32 * bj) = pack8(acc[ai][bj][m][0], acc[ai][bj][m][1]); }
        } else if (pn < 6) {
            const bool isq = pn < 4;
            bf16_t* base = isq ? (Q + (pn - 2) * 256) : (K + (pn - 4) * 256);
            const float* g = isq ? qg : kg; const float mul = isq ? QK_C2 : 1.0f;
            f32x4 gv[2][2];
#pragma unroll
            for (int bj = 0; bj < 2; ++bj)
#pragma unroll
                for (int n = 0; n < 2; ++n) gv[bj][n] = *(const f32x4*)(g + 32 * bj + 8 * fq + 4 * n) * mul;
#pragma unroll
            for (int ai = 0; ai < 2; ++ai)
#pragma unroll
                for (int m = 0; m < 4; ++m) { float ss = 0.f;
#pragma unroll
                    for (int bj = 0; bj < 2; ++bj)
#pragma unroll
                        for (int n = 0; n < 2; ++n) ss += dot4(acc[ai][bj][m][n]);
                    ss += __shfl_xor(ss, 16); ss += __shfl_xor(ss, 32);
                    const float r = __builtin_amdgcn_rsqf(ss * (1.0f / 64.0f) + 1e-6f);
                    bf16_t* rowp = base + (size_t)(row0 + ai * HALF + m * 16) * 512 + cw;
#pragma unroll
                    for (int bj = 0; bj < 2; ++bj) *(u32x4*)(rowp + 32 * bj) = pack8(acc[ai][bj][m][0] * r * gv[bj][0], acc[ai][bj][m][1] * r * gv[bj][1]); }
        } else {
            const int gc = (pn - 8) * 256 + cw;
            f32x4 bv[2][2];
#pragma unroll
            for (int bj = 0; bj < 2; ++bj)
#pragma unroll
                for (int n = 0; n < 2; ++n) bv[bj][n] = *(const f32x4*)(gb + gc + 32 * bj + 4 * n);
#pragma unroll
            for (int ai = 0; ai < 2; ++ai)
#pragma unroll
                for (int m = 0; m < 4; ++m) { bf16_t* rowp = G + (size_t)(row0 + ai * HALF + m * 16) * 2048 + gc;
#pragma unroll
                    for (int bj = 0; bj < 2; ++bj) *(u32x4*)(rowp + 32 * bj) = pack8(sigmoid4(acc[ai][bj][m][0] + bv[bj][0]), sigmoid4(acc[ai][bj][m][1] + bv[bj][1])); }
        }
    }
};
struct EpiMerge {
    static constexpr bool PERM = true, AFTER_DRAIN = false, HOOK = true, INIT = false; static constexpr int HOOK_T = 8;
    const bf16_t* G; bf16_t* MG;
    __device__ __forceinline__ void hook(f32x4 (&acc)[2][2][4][2], const Unit& u, int wr, int wc, int fr, int fq) const {
        asm volatile("" : "+v"(fr), "+v"(fq));
        const int row0 = u.pm * BM + wr * 64 + fr, col0 = u.pn * BM + wc * 32 + 8 * fq;
#pragma unroll
        for (int ai = 0; ai < 2; ++ai)
#pragma unroll
            for (int m = 0; m < 4; ++m) { const size_t row = (size_t)(row0 + ai * HALF + m * 16);
#pragma unroll
                for (int bj = 0; bj < 2; ++bj) { const int c = col0 + bj * HALF; f32x4 a0, a1, b0, b1; unpack8(*(const u32x4*)(G + row * 2048 + c), a0, a1); unpack8(*(const u32x4*)(G + row * 2048 + 1024 + c), b0, b1);
#pragma unroll
                    for (int e = 0; e < 4; ++e) { a0[e] *= __builtin_amdgcn_rcpf(__builtin_fmaxf(b0[e], 1e-30f)); a1[e] *= __builtin_amdgcn_rcpf(__builtin_fmaxf(b1[e], 1e-30f)); }
                    acc[ai][bj][m][0] *= a0; acc[ai][bj][m][1] *= a1; }
                if (m == 3) asm volatile("" ::: "memory"); }
    }
    __device__ __forceinline__ void operator()(const f32x4 (&acc)[2][2][4][2], const Unit& u, int wr, int wc, int fr, int fq) const {
        const int row0 = u.pm * BM + wr * 64 + fr, col0 = u.pn * BM + wc * 32 + 8 * fq;
#pragma unroll
        for (int ai = 0; ai < 2; ++ai)
#pragma unroll
            for (int m = 0; m < 4; ++m) { const size_t row = (size_t)(row0 + ai * HALF + m * 16);
#pragma unroll
                for (int bj = 0; bj < 2; ++bj) { const int c = col0 + bj * HALF; f32x4 b0, b1; unpack8(*(const u32x4*)(G + row * 2048 + 1024 + c), b0, b1);
                    *(u32x4*)(MG + row * 1024 + c) = pack8(acc[ai][bj][m][0] * b0, acc[ai][bj][m][1] * b1); } }
    }
};
struct EpiOut {
    static constexpr bool PERM = true, AFTER_DRAIN = false, HOOK = false, INIT = true;
    const float* X; bf16_t* X1B; float* SSQ;
    __device__ __forceinline__ void init(f32x4 (&acc)[2][2][4][2], const Unit& u, int wr, int wc, int fr, int fq) const {
        const int row0 = u.pm * BM + wr * 64 + fr, col0 = u.pn * BM + wc * 32 + 8 * fq;
#pragma unroll
        for (int ai = 0; ai < 2; ++ai)
#pragma unroll
            for (int m = 0; m < 4; ++m) { const size_t row = (size_t)(row0 + ai * HALF + m * 16);
#pragma unroll
                for (int bj = 0; bj < 2; ++bj) { const int c = col0 + bj * HALF; acc[ai][bj][m][0] = *(const f32x4*)(X + row * 1024 + c); acc[ai][bj][m][1] = *(const f32x4*)(X + row * 1024 + c + 4); } }
    }
    __device__ __forceinline__ void operator()(const f32x4 (&acc)[2][2][4][2], const Unit& u, int wr, int wc, int fr, int fq) const {
        const int row0 = u.pm * BM + wr * 64 + fr, col0 = u.pn * BM + wc * 32 + 8 * fq;
#pragma unroll
        for (int ai = 0; ai < 2; ++ai)
#pragma unroll
            for (int m = 0; m < 4; ++m) { const size_t row = (size_t)(row0 + ai * HALF + m * 16); float ss = 0.f;
#pragma unroll
                for (int bj = 0; bj < 2; ++bj) { const int c = col0 + bj * HALF;
                    const f32x4 v0 = acc[ai][bj][m][0], v1 = acc[ai][bj][m][1];
                    *(u32x4*)(X1B + row * 1024 + c) = pack8(v0, v1);
                    ss += dot4(v0) + dot4(v1); }
                ss += __shfl_xor(ss, 16); ss += __shfl_xor(ss, 32);
                if (fq == 0) SSQ[row * 16 + u.pn * 4 + wc] = ss; }
    }
};
struct EpiFF1 {
    static constexpr bool PERM = true, AFTER_DRAIN = false, HOOK = false, INIT = false;
    const float* SSQ; bf16_t* H; int pm_tab; const PG8_LAS float* rtab;
    __device__ __forceinline__ void operator()(const f32x4 (&acc)[2][2][4][2], const Unit& u, int wr, int wc, int fr, int fq) const {
        const int row0 = u.pm * BM + wr * 64 + fr, col0 = u.pn * BM + wc * 32 + 8 * fq;
        const bool tab = (u.pm == pm_tab);
#pragma unroll
        for (int ai = 0; ai < 2; ++ai)
#pragma unroll
            for (int m = 0; m < 4; ++m) { const size_t row = (size_t)(row0 + ai * HALF + m * 16);
                float r;
                if (tab) r = rtab[ai * HALF + wr * 64 + m * 16 + fr];
                else { const f32x4* sp = (const f32x4*)(SSQ + row * 16); const f32x4 s4 = (sp[0] + sp[1]) + (sp[2] + sp[3]);
                    r = __builtin_amdgcn_rsqf(((s4[0] + s4[1]) + (s4[2] + s4[3])) * (1.0f / 1024.0f) + 1e-6f); }
#pragma unroll
                for (int bj = 0; bj < 2; ++bj) { const int c = col0 + bj * HALF; f32x4 v0 = acc[ai][bj][m][0] * r, v1 = acc[ai][bj][m][1] * r;
#pragma unroll
                    for (int e = 0; e < 4; ++e) { v0[e] = __builtin_fmaxf(v0[e], 0.f); v1[e] = __builtin_fmaxf(v1[e], 0.f); }
                    *(u32x4*)(H + row * 4096 + c) = pack8(v0 * v0, v1 * v1); } }
    }
};
struct EpiFF2 {
    static constexpr bool PERM = true, AFTER_DRAIN = false, HOOK = false, INIT = true;
    const bf16_t* X1B; float* OUT;
    __device__ __forceinline__ void init(f32x4 (&acc)[2][2][4][2], const Unit& u, int wr, int wc, int fr, int fq) const {
        const int row0 = u.pm * BM + wr * 64 + fr, col0 = u.pn * BM + wc * 32 + 8 * fq;
#pragma unroll
        for (int ai = 0; ai < 2; ++ai)
#pragma unroll
            for (int m = 0; m < 4; ++m) { const size_t row = (size_t)(row0 + ai * HALF + m * 16);
#pragma unroll
                for (int bj = 0; bj < 2; ++bj) { const int c = col0 + bj * HALF; unpack8(*(const u32x4*)(X1B + row * 1024 + c), acc[ai][bj][m][0], acc[ai][bj][m][1]); } }
    }
    __device__ __forceinline__ void operator()(const f32x4 (&acc)[2][2][4][2], const Unit& u, int wr, int wc, int fr, int fq) const {
        const int row0 = u.pm * BM + wr * 64 + fr, col0 = u.pn * BM + wc * 32 + 8 * fq;
#pragma unroll
        for (int ai = 0; ai < 2; ++ai)
#pragma unroll
            for (int m = 0; m < 4; ++m) { const size_t row = (size_t)(row0 + ai * HALF + m * 16);
#pragma unroll
                for (int bj = 0; bj < 2; ++bj) { float* p = OUT + row * 1024 + col0 + bj * HALF; *(f32x4*)p = acc[ai][bj][m][0]; *(f32x4*)(p + 4) = acc[ai][bj][m][1]; } }
    }
};

template <class Epi, class Sched, bool ALIGN_EPI = false, bool SP2 = false>
__device__ __forceinline__ void gemm_phase(PG8_LAS unsigned char* lds, const Gemm g, const Sched& S, const Epi& E) {
    const int tid = threadIdx.x, wid = __builtin_amdgcn_readfirstlane(tid >> 6), lane = tid & 63, wr = wid >> 2, wc = wid & 3, fr = lane & 15, fq = lane >> 4;
    const int K = g.K, nt = K / BK;
    unsigned voffA[2], voffB[2];
#pragma unroll
    for (int i = 0; i < 2; ++i) { int R, C; stage_rc(tid * 16 + i * 8192, R, C); const int Rb = Epi::PERM ? ((R & ~31) + perm32(R & 31)) : R;
        voffA[i] = (unsigned)(R * K + C) * 2u; voffB[i] = (unsigned)(Rb * K + C) * 2u; }
    const size_t kstep = (size_t)(BK * 2);
    const size_t hstep = (size_t)HALF * K * 2;
    const size_t tstep = 2 * hstep;
    const unsigned ldsw = (unsigned)wid * 1024u;
    const int aoff = lds_byte(wr * 64 + fr, fq * 8), boff = lds_byte(wc * 32 + fr, fq * 8);
#define PG8_SA(b, h) (((b) * 2 + (h)) * HTB)
#define PG8_SB(b, h) ((4 + (b) * 2 + (h)) * HTB)
#define PG8_STAGE(bufoff, gbase, voff) do { _Pragma("unroll") for (int _i = 0; _i < 2; ++_i) \
        __builtin_amdgcn_global_load_lds((const unsigned*)((const char*)(gbase) + (voff)[_i]), (PG8_LAS unsigned*)(lds + (bufoff) + ldsw + _i * 8192), 16, 0, 0); } while (0)
#define PG8_LDA(dst, b, h) do { _Pragma("unroll") for (int m = 0; m < 4; ++m) _Pragma("unroll") for (int k = 0; k < 2; ++k) dst[m][k] = *(const PG8_LAS bf16x8*)(lds + PG8_SA(b, h) + aoff + m * 2048 + k * 1024); } while (0)
#define PG8_LDB(dst, b, h) do { _Pragma("unroll") for (int n = 0; n < 2; ++n) _Pragma("unroll") for (int k = 0; k < 2; ++k) dst[n][k] = *(const PG8_LAS bf16x8*)(lds + PG8_SB(b, h) + boff + n * 2048 + k * 1024); } while (0)
#define PG8_MMA(ai, bj, At, Bt) do { __builtin_amdgcn_s_setprio(1); _Pragma("unroll") for (int m = 0; m < 4; ++m) _Pragma("unroll") for (int n = 0; n < 2; ++n) _Pragma("unroll") for (int k = 0; k < 2; ++k) \
        acc[ai][bj][m][n] = __builtin_amdgcn_mfma_f32_16x16x32_bf16(Bt[n][k], At[m][k], acc[ai][bj][m][n], 0, 0, 0); __builtin_amdgcn_s_setprio(0); } while (0)
#define PG8_WAIT_V(n) asm volatile("s_waitcnt vmcnt(" #n ")" ::: "memory")
#define PG8_WAIT_L(n) asm volatile("s_waitcnt lgkmcnt(" #n ")" ::: "memory")
#define PG8_BAR __builtin_amdgcn_s_barrier()
#define PG8_SCHED __builtin_amdgcn_sched_barrier(0)
    Unit cur, nxt; int ui = 0;
    if (!S.next(0, cur)) return;
    f32x4 acc[2][2][4][2];
    if constexpr (!Epi::INIT) {
#pragma unroll
    for (int a = 0; a < 2; ++a)
#pragma unroll
        for (int b = 0; b < 2; ++b)
#pragma unroll
            for (int m = 0; m < 4; ++m)
#pragma unroll
                for (int n = 0; n < 2; ++n) acc[a][b][m][n] = (f32x4){0.f, 0.f, 0.f, 0.f};
    }
    bf16x8 At[4][2], B0[2][2], B1[2][2];
    const char* cA = (const char*)g.A + (size_t)cur.pm * tstep; const char* cB = (const char*)g.Bt + (size_t)cur.pn * tstep;
    S.a_ready(cur);
    if constexpr (SP2) {
        PG8_STAGE(PG8_SB(0, 0), cB, voffB); PG8_STAGE(PG8_SB(0, 1), cB + hstep, voffB); PG8_STAGE(PG8_SA(0, 0), cA, voffA); PG8_STAGE(PG8_SA(0, 1), cA + hstep, voffA);
        if constexpr (Epi::INIT) E.init(acc, cur, wr, wc, fr, fq);
        if (wr == 1) PG8_BAR;
        PG8_WAIT_V(2); PG8_BAR;
        PG8_STAGE(PG8_SB(1, 0), cB + kstep, voffB); PG8_STAGE(PG8_SA(1, 0), cA + kstep, voffA); PG8_STAGE(PG8_SB(1, 1), cB + hstep + kstep, voffB);
        PG8_WAIT_V(6); PG8_BAR;
    } else {
        PG8_STAGE(PG8_SB(0, 0), cB, voffB); PG8_STAGE(PG8_SA(0, 0), cA, voffA); PG8_STAGE(PG8_SB(0, 1), cB + hstep, voffB); PG8_STAGE(PG8_SA(0, 1), cA + hstep, voffA);
        if constexpr (Epi::INIT) E.init(acc, cur, wr, wc, fr, fq);
        if (wr == 1) PG8_BAR;
        PG8_WAIT_V(4); PG8_BAR;
        PG8_STAGE(PG8_SB(1, 0), cB + kstep, voffB); PG8_STAGE(PG8_SA(1, 0), cA + kstep, voffA); PG8_STAGE(PG8_SB(1, 1), cB + hstep + kstep, voffB);
        PG8_WAIT_V(6); PG8_BAR;
    }
    for (;;) {
        const bool has_next = S.next(ui + 1, nxt);
        const char* nA = has_next ? (const char*)g.A + (size_t)nxt.pm * tstep : cA; const char* nB = has_next ? (const char*)g.Bt + (size_t)nxt.pn * tstep : cB;
        for (int t = 0; t < nt; t += 2) {
            const bool last = (t == nt - 2);
            if constexpr (Epi::HOOK) { if (t == Epi::HOOK_T) E.hook(acc, cur, wr, wc, fr, fq); }
            const char* a1 = cA + (size_t)(t + 1) * kstep;
            const char* a2 = last ? nA : cA + (size_t)(t + 2) * kstep; const char* b2 = last ? nB : cB + (size_t)(t + 2) * kstep;
            const char* a3 = a2 + kstep; const char* b3 = b2 + kstep;
            if (last && has_next) S.a_ready(nxt);
            if constexpr (SP2) {
            PG8_LDB(B0, 0, 0); PG8_LDB(B1, 0, 1); PG8_SCHED; PG8_LDA(At, 0, 0); PG8_STAGE(PG8_SA(1, 1), a1 + hstep, voffA);
            PG8_WAIT_V(8); PG8_WAIT_L(0); PG8_BAR; PG8_MMA(0, 0, At, B0); PG8_MMA(0, 1, At, B1); PG8_BAR; PG8_SCHED;
            PG8_LDA(At, 0, 1); PG8_STAGE(PG8_SB(0, 0), b2, voffB); PG8_STAGE(PG8_SB(0, 1), b2 + hstep, voffB); PG8_STAGE(PG8_SA(0, 0), a2, voffA);
            PG8_WAIT_V(8); PG8_WAIT_L(0); PG8_BAR; PG8_MMA(1, 0, At, B0); PG8_MMA(1, 1, At, B1); PG8_BAR; PG8_SCHED;
            PG8_LDB(B0, 1, 0); PG8_LDB(B1, 1, 1); PG8_SCHED; PG8_LDA(At, 1, 0); PG8_STAGE(PG8_SA(0, 1), a2 + hstep, voffA);
            PG8_WAIT_V(8); PG8_WAIT_L(0); PG8_BAR; PG8_MMA(0, 0, At, B0); PG8_MMA(0, 1, At, B1); PG8_BAR; PG8_SCHED;
            PG8_LDA(At, 1, 1); PG8_STAGE(PG8_SB(1, 0), b3, voffB); PG8_STAGE(PG8_SB(1, 1), b3 + hstep, voffB); PG8_STAGE(PG8_SA(1, 0), a3, voffA);
            PG8_WAIT_V(8); PG8_WAIT_L(0); PG8_BAR; PG8_MMA(1, 0, At, B0); PG8_MMA(1, 1, At, B1); PG8_BAR; PG8_SCHED;
            } else {
            PG8_LDB(B0, 0, 0); PG8_SCHED; PG8_LDA(At, 0, 0); PG8_STAGE(PG8_SA(1, 1), a1 + hstep, voffA);
            PG8_WAIT_L(8); PG8_BAR; PG8_WAIT_L(0); PG8_MMA(0, 0, At, B0); PG8_BAR; PG8_SCHED;
            PG8_LDB(B1, 0, 1); PG8_STAGE(PG8_SB(0, 0), b2, voffB);
            PG8_BAR; PG8_WAIT_L(0); PG8_MMA(0, 1, At, B1); PG8_BAR;
            PG8_LDA(At, 0, 1); PG8_STAGE(PG8_SA(0, 0), a2, voffA);
            PG8_BAR; PG8_WAIT_L(0); PG8_MMA(1, 0, At, B0); PG8_BAR; PG8_SCHED;
            PG8_STAGE(PG8_SB(0, 1), b2 + hstep, voffB);
            PG8_WAIT_V(6); PG8_BAR; PG8_MMA(1, 1, At, B1); PG8_BAR;
            PG8_LDB(B0, 1, 0); PG8_SCHED; PG8_LDA(At, 1, 0); PG8_STAGE(PG8_SA(0, 1), a2 + hstep, voffA);
            PG8_WAIT_L(8); PG8_BAR; PG8_WAIT_L(0); PG8_MMA(0, 0, At, B0); PG8_BAR; PG8_SCHED;
            PG8_LDB(B1, 1, 1); PG8_STAGE(PG8_SB(1, 0), b3, voffB);
            PG8_BAR; PG8_WAIT_L(0); PG8_MMA(0, 1, At, B1); PG8_BAR;
            PG8_LDA(At, 1, 1); PG8_STAGE(PG8_SA(1, 0), a3, voffA);
            PG8_BAR; PG8_WAIT_L(0); PG8_MMA(1, 0, At, B0); PG8_BAR; PG8_SCHED;
            PG8_STAGE(PG8_SB(1, 1), b3 + hstep, voffB);
            PG8_WAIT_V(6); PG8_BAR; PG8_MMA(1, 1, At, B1); PG8_BAR;
            }
        }
        if constexpr (ALIGN_EPI) { if (wr == 0) PG8_BAR; }
        if constexpr (!Epi::AFTER_DRAIN) { E(acc, cur, wr, wc, fr, fq); S.done(cur); }
        if (!has_next) break;
        if constexpr (Epi::INIT) E.init(acc, nxt, wr, wc, fr, fq); else
#pragma unroll
        for (int a = 0; a < 2; ++a)
#pragma unroll
            for (int b = 0; b < 2; ++b)
#pragma unroll
                for (int m = 0; m < 4; ++m)
#pragma unroll
                    for (int n = 0; n < 2; ++n) acc[a][b][m][n] = (f32x4){0.f, 0.f, 0.f, 0.f};
        cur = nxt; cA = nA; cB = nB; ++ui;
        if constexpr (ALIGN_EPI) { if (wr == 1) PG8_BAR; }
    }
    PG8_WAIT_V(0);
    if constexpr (!ALIGN_EPI) { if (wr == 0) PG8_BAR; }
    PG8_BAR;
    if constexpr (Epi::AFTER_DRAIN) { E.fused(acc, cur, wr, wc, fr, fq, lds, wid, lane); S.done(cur); }
#undef PG8_SA
#undef PG8_SB
#undef PG8_STAGE
#undef PG8_LDA
#undef PG8_LDB
#undef PG8_MMA
#undef PG8_WAIT_V
#undef PG8_WAIT_L
#undef PG8_BAR
#undef PG8_SCHED
}
}
namespace attn_body {
using bf16=__hip_bfloat16;
using bf16x8=__attribute__((ext_vector_type(8)))short;
using s16x4=__attribute__((ext_vector_type(4)))short;
using f32x16=__attribute__((ext_vector_type(16)))float;
using u32x4=__attribute__((ext_vector_type(4)))unsigned;
constexpr int BATCH=2,NHEAD=16,SEQ=8192,D=64,DM=512,PO=1024;
constexpr int NW=8,QBLK=32,QB=QBLK*NW,KVBLK=64,NQB=SEQ/QB;
constexpr int ATTN_UNIT_ROWS=QB;
__device__ __forceinline__ int crow(int r,int hi){return (r&3)+8*(r>>2)+4*hi;}
#define SBAR() __builtin_amdgcn_sched_barrier(0)
__device__ __forceinline__ void cmask(f32x16&p0,f32x16&p1,int jb,int qrel,int hi){
  const float NEG=-INFINITY; int kb=64*jb+4*hi;
  #pragma unroll
  for(int r=0;r<16;++r){int kv=kb+(r&3)+8*(r>>2); if(kv>qrel)p0[r]=NEG; if(kv+32>qrel)p1[r]=NEG;}
}

constexpr int NSLOT=3, SLOTB=8192;
constexpr int LDS_K=0, LDS_V=NSLOT*SLOTB, LDS_WS=2*NSLOT*SLOTB, LDS_OST=LDS_WS+NW*64*4, LDS_BYTES=LDS_OST+NW*4096;
constexpr float C2=0.125f*1.4426950408889634f;
__device__ __forceinline__ void glds16(const void*gsrc,unsigned lds_dst){unsigned keep;
  asm volatile("s_mov_b32 %0, m0\n\ts_mov_b32 m0, %2\n\ts_nop 0\n\tglobal_load_lds_dwordx4 %1, off\n\ts_mov_b32 m0, %0":"=&s"(keep):"v"(gsrc),"s"(lds_dst):"memory");}
__device__ __forceinline__ void glds16s(const void*sbase,unsigned voff,unsigned lds_dst){unsigned keep;
  asm volatile("s_mov_b32 %0, m0\n\ts_mov_b32 m0, %3\n\ts_nop 0\n\tglobal_load_lds_dwordx4 %1, %2\n\ts_mov_b32 m0, %0":"=&s"(keep):"v"(voff),"s"(sbase),"s"(lds_dst):"memory");}
__device__ __forceinline__ float max3f(float a,float b,float c){float r;asm("v_max3_f32 %0, %1, %2, %3":"=v"(r):"v"(a),"v"(b),"v"(c));return r;}
__device__ __forceinline__ float max2f(float a,float b){float r;asm("v_max_f32_e32 %0, %1, %2":"=v"(r):"v"(a),"v"(b));return r;}
__device__ __forceinline__ float fadd_s(float a,float b){float r;asm("v_add_f32_e32 %0, %1, %2":"=v"(r):"v"(a),"v"(b));return r;}
__device__ __forceinline__ float fsub_s(float a,float b){float r;asm("v_sub_f32_e32 %0, %1, %2":"=v"(r):"v"(a),"v"(b));return r;}
typedef float f32x2_t __attribute__((ext_vector_type(2))); typedef __bf16 bf16x2_t __attribute__((ext_vector_type(2)));
__device__ __forceinline__ unsigned cvtpk_s(float lo,float hi){f32x2_t v={lo,hi};bf16x2_t b=__builtin_convertvector(v,bf16x2_t);return __builtin_bit_cast(unsigned,b);}
#define WAIT_BAR(N) asm volatile("s_waitcnt vmcnt(" #N ") lgkmcnt(0)\n\ts_barrier":::"memory")

__device__ __forceinline__ void qkt(f32x16&p0,f32x16&p1,const char*Kslot,const bf16x8*qr,const f32x16&negm,int r32,int hi){
  const char*kb=Kslot+hi*1024+r32*16;
  #pragma unroll
  for(int d0=0;d0<4;++d0){
    const bf16x8 b0=*reinterpret_cast<const bf16x8*>(kb+d0*2048);
    const bf16x8 b1=*reinterpret_cast<const bf16x8*>(kb+d0*2048+512);
    if(d0==0){p0=__builtin_amdgcn_mfma_f32_32x32x16_bf16(b0,qr[0],negm,0,0,0);p1=__builtin_amdgcn_mfma_f32_32x32x16_bf16(b1,qr[0],negm,0,0,0);}
    else{p0=__builtin_amdgcn_mfma_f32_32x32x16_bf16(b0,qr[d0],p0,0,0,0);p1=__builtin_amdgcn_mfma_f32_32x32x16_bf16(b1,qr[d0],p1,0,0,0);}}
}
typedef __attribute__((address_space(3))) const char* lds_cptr;
typedef short v4i16_t __attribute__((ext_vector_type(4)));
__device__ __forceinline__ void kload8(bf16x8*kf,lds_cptr kp){
  kf[0]=*(const __attribute__((address_space(3))) bf16x8*)(kp);      kf[1]=*(const __attribute__((address_space(3))) bf16x8*)(kp+512);
  kf[2]=*(const __attribute__((address_space(3))) bf16x8*)(kp+2048); kf[3]=*(const __attribute__((address_space(3))) bf16x8*)(kp+2560);
  kf[4]=*(const __attribute__((address_space(3))) bf16x8*)(kp+4096); kf[5]=*(const __attribute__((address_space(3))) bf16x8*)(kp+4608);
  kf[6]=*(const __attribute__((address_space(3))) bf16x8*)(kp+6144); kf[7]=*(const __attribute__((address_space(3))) bf16x8*)(kp+6656);
}
__device__ __forceinline__ void kload2(bf16x8*kf,lds_cptr kp,int j){ kf[2*j]=*(const __attribute__((address_space(3))) bf16x8*)(kp+j*2048); kf[2*j+1]=*(const __attribute__((address_space(3))) bf16x8*)(kp+j*2048+512); }
__device__ __forceinline__ s16x4 vtr(lds_cptr p){ return __builtin_bit_cast(s16x4,__builtin_amdgcn_ds_read_tr16_b64_v4i16((__attribute__((address_space(3))) v4i16_t*)p)); }
__device__ __forceinline__ float rowmax(const f32x16&p0,const f32x16&p1){
  float a=max3f(p0[0],p0[1],p1[0]),b=max3f(p0[2],p0[3],p1[1]);a=max3f(a,p1[2],p1[3]);
  #pragma unroll
  for(int r=4;r<16;r+=4){a=max3f(a,p0[r],p0[r+1]);b=max3f(b,p0[r+2],p0[r+3]);a=max3f(a,p1[r],p1[r+1]);b=max3f(b,p1[r+2],p1[r+3]);}
  const float m=max2f(a,b);
  auto rr=__builtin_amdgcn_permlane32_swap(__float_as_uint(m),__float_as_uint(m),false,false);
  return max2f(__uint_as_float(rr[0]),__uint_as_float(rr[1]));
}
__device__ __forceinline__ void pv(f32x16*o,int vb,bf16x8 pa0,bf16x8 pa1,bf16x8 pa2,bf16x8 pa3){
  #pragma unroll
  for(int d0=0;d0<2;++d0){s16x4 lo[4],hi[4];
    #pragma unroll
    for(int ks=0;ks<4;++ks){
      asm volatile("ds_read_b64_tr_b16 %0,%1 offset:%c2":"=&v"(lo[ks]):"v"(vb),"i"(d0*4096+ks*1024):"memory");
      asm volatile("ds_read_b64_tr_b16 %0,%1 offset:%c2":"=&v"(hi[ks]):"v"(vb),"i"(d0*4096+ks*1024+512):"memory");}
    asm volatile("s_waitcnt lgkmcnt(0)":::"memory");SBAR();
    #define PK(k) (bf16x8){lo[k][0],lo[k][1],lo[k][2],lo[k][3],hi[k][0],hi[k][1],hi[k][2],hi[k][3]}
    o[d0]=__builtin_amdgcn_mfma_f32_32x32x16_bf16(pa0,PK(0),o[d0],0,0,0);
    o[d0]=__builtin_amdgcn_mfma_f32_32x32x16_bf16(pa1,PK(1),o[d0],0,0,0);
    o[d0]=__builtin_amdgcn_mfma_f32_32x32x16_bf16(pa2,PK(2),o[d0],0,0,0);
    o[d0]=__builtin_amdgcn_mfma_f32_32x32x16_bf16(pa3,PK(3),o[d0],0,0,0);
    #undef PK
  }
}

#ifndef ATTN_STORE16
#define ATTN_STORE16(p,v) (*(u32x4*)(p)=(v))
#endif
template<int THRL> __device__ __forceinline__ void attn_unit(int b,int vh,int qb,const bf16*Q,const bf16*__restrict__ K,const bf16*__restrict__ V,bf16*O,char*shm,float smax2,bool NOMAX){
  const int qkoff=(vh>>1)*64, voff=(vh>>2)*128+(vh&1)*64;
  const int tid=threadIdx.x,lane=tid&63,r32=lane&31,hi=lane>>5; const int wid=__builtin_amdgcn_readfirstlane(tid>>6);
  const long rowbase=(long)b*SEQ; const int q0=qb*QB;
  const float slope2=__builtin_ldexpf(1.4426950408889634f,-2*((vh>>2)+1));
  int t0; { const float win=(150.f+smax2)/slope2; int tt=(int)floorf(((float)(q0-63)-win)*(1.f/64.f)); tt=tt<0?0:tt; tt&=~1; const int tmax=(q0+QB)/KVBLK-4; tt=tt>tmax?tmax:tt; t0=__builtin_amdgcn_readfirstlane(tt); }
  const long kvbase=rowbase+(long)t0*KVBLK;
  const bf16*Qw=Q+(rowbase+q0+wid*QBLK)*DM+qkoff;
  const bf16*Kh=K+kvbase*DM+qkoff,*Vh=V+kvbase*DM+voff;
  const unsigned lds0=(unsigned)(uintptr_t)shm;
  float*wsf=(float*)(shm+LDS_WS)+wid*64;
  const unsigned koff_=(unsigned)(lane*DM*2), voff_=(unsigned)(((lane>>2)*DM+(lane&3)*8)*2);
  const char*kbase_=(const char*)(Kh+wid*8); const char*vbase_=(const char*)(Vh+(long)(16*(wid&3))*DM+(wid>>2)*32);
  const unsigned kdst=lds0+LDS_K+wid*1024, vdst=lds0+LDS_V+wid*1024;
  #define DMA_K(t,slot) glds16s(kbase_+(long)(t)*(KVBLK*DM*2),koff_,(unsigned)__builtin_amdgcn_readfirstlane(kdst+(slot)))
  #define DMA_V(t,slot) glds16s(vbase_+(long)(t)*(KVBLK*DM*2),voff_,(unsigned)__builtin_amdgcn_readfirstlane(vdst+(slot)))
  const int vb0=(int)(lds0+LDS_V)+((lane>>4)&1)*32+(lane&3)*8+(4*hi+((lane&15)>>2))*64;
  const char*Kbase=shm+LDS_K; bf16x8 kf[8];
  const lds_cptr shm3=(lds_cptr)shm; const lds_cptr kp0=shm3+LDS_K+hi*1024+r32*16; const lds_cptr vp0=shm3+LDS_V+((lane>>4)&1)*32+(lane&3)*8+(4*hi+((lane&15)>>2))*64;
  const int NT=(q0+QB)/KVBLK-t0;
  DMA_K(0,0);DMA_V(0,0);DMA_K(1,SLOTB);
  bf16x8 qr[4];
  #pragma unroll
  for(int d0=0;d0<4;++d0)qr[d0]=*reinterpret_cast<const bf16x8*>(&Qw[(long)r32*DM+d0*16+hi*8]);
  float l_reg=0.f;f32x16 o[2];o[0]=f32x16{};o[1]=f32x16{};f32x16 negm;
  const unsigned esh_=(unsigned)(2*((vh>>2)+1))<<23;
  #define SLC(c) ((c)==0?0.f:__uint_as_float(__float_as_uint(1.4426950408889634f*(float)(c))-esh_))
  float scr_[16];
  #pragma unroll
  for(int r=0;r<16;++r)scr_[r]=SLC((r&3)+8*(r>>2));
  const float s32=SLC(32), s64=SLC(64);
  float cb=slope2*(float)(4*hi+KVBLK*t0-(q0+QB-1));
  #define SETC() do{ _Pragma("unroll") for(int r=0;r<16;++r)negm[r]=cb+scr_[r]; asm volatile("":"+v"(negm)); }while(0)
  #define ADD32(P1) do{ _Pragma("unroll") for(int r=0;r<16;++r)P1[r]+=s32; }while(0)
  SETC();
  const int qrel=wid*QBLK+r32;
  #define CMASK(P0,P1,t) do{int jb_=(t)-(NT-4); if(jb_>=0)cmask(P0,P1,jb_,qrel,hi);}while(0)
  bool resc=false;
  #define START(P0,P1) do{ resc=false; \
    { float dl=slope2*(float)(qrel-(QB-1)); if(!NOMAX){ dl=__builtin_fmaxf(rowmax(P0,P1),dl); } cb=fsub_s(cb,dl); \
      _Pragma("unroll") for(int r=0;r<16;++r){P0[r]=fsub_s(P0[r],dl);P1[r]=fsub_s(P1[r],dl);} \
      cb+=s64; SETC(); } \
    _Pragma("unroll") for(int r=0;r<16;++r)P0[r]=__builtin_amdgcn_exp2f(P0[r]); }while(0)
  #define RESC() do{ if(resc){ asm volatile("s_waitcnt lgkmcnt(0)":::"memory"); \
      _Pragma("unroll") for(int d_=0;d_<2;++d_) _Pragma("unroll") for(int r=0;r<16;++r)o[d_][r]*=wsf[crow(r,hi)]; } }while(0)
  f32x16 pA0,pA1,pB0,pB1;
  int sl_prev=0,sl_cur=0,sl_next=SLOTB;
  #define ROT() do{sl_prev=sl_cur;sl_cur=sl_next;sl_next=(sl_next==(NSLOT-1)*SLOTB)?0:sl_next+SLOTB;}while(0)
  DMA_K(2,2*SLOTB);
  WAIT_BAR(3);
  qkt(pA0,pA1,Kbase,qr,negm,r32,hi);asm volatile("s_nop 15\n\ts_nop 7":"+v"(pA0),"+v"(pA1));ADD32(pA1);CMASK(pA0,pA1,0);
  START(pA0,pA1);
  _Pragma("unroll") for(int r=0;r<16;++r)pA1[r]=__builtin_amdgcn_exp2f(pA1[r]);
  WAIT_BAR(0);
  DMA_K(3,0);DMA_V(1,SLOTB);
  ROT();
  kload8(kf,kp0+sl_cur);
  WAIT_BAR(2);
  s16x4 vlo[8],vhi[8]; u32x4 pw0,pw1,pw2,pw3;
  #define PKW(P,B) cvtpk_s(P[B],P[B+1])
  #define PAF(k) __builtin_bit_cast(bf16x8,pw##k)
  #define VFR(i) (bf16x8){vlo[i][0],vlo[i][1],vlo[i][2],vlo[i][3],vhi[i][0],vhi[i][1],vhi[i][2],vhi[i][3]}
  #define PIN(x) asm volatile("":"+v"(x))
  #define MX3(a,b,c) __builtin_fmaxf(__builtin_fmaxf((a),(b)),(c))
  #define PR2(P,i) __builtin_shufflevector(P,P,i,i+1)
  #define GAPA(MF,Q0,Q1,W0,W1,PW) do{ MF; sacc2+=Q0; sacc2+=Q1; PIN(sacc2); W0; W1; PIN(PW); SBAR(); }while(0)
  #define GAPA1(MF,Q0,W0,W1,PW) do{ MF; sacc2+=Q0; PIN(sacc2); W0; W1; PIN(PW); SBAR(); }while(0)
  #define EX(v) __builtin_amdgcn_exp2f(v)
  #define GAPB(MF,X,B) do{ MF; X[B]=EX(X[B]); X[B+1]=EX(X[B+1]); X[B+2]=EX(X[B+2]); X[B+3]=EX(X[B+3]); PIN(X); SBAR(); }while(0)
  #define VRD(i) do{ vlo[i]=vtr(vp_+(((i)>>2)*4096+((i)&3)*1024)); vhi[i]=vtr(vp_+(((i)>>2)*4096+((i)&3)*1024+512)); }while(0)
  #define KRD(G,j) do{ if(G){ kload2(kf,kp0+sl_next,j); SBAR(); } }while(0)
  #define STEP(C0,C1,P0,P1,t,GK,GV,GL) do{ SBAR(); \
    const lds_cptr vp_=vp0+sl_prev; \
    VRD(0); SBAR(); f32x2_t sacc2=PR2(P0,0); \
    GAPA(C0=__builtin_amdgcn_mfma_f32_32x32x16_bf16(kf[0],qr[0],negm,0,0,0), PR2(P0,2),PR2(P0,4),     pw0[0]=PKW(P0,0), pw0[1]=PKW(P0,2), pw0); \
    VRD(4); SBAR(); GAPA(C1=__builtin_amdgcn_mfma_f32_32x32x16_bf16(kf[1],qr[0],negm,0,0,0), PR2(P0,6),PR2(P0,8),     pw0[2]=PKW(P0,4), pw0[3]=PKW(P0,6), pw0); \
    VRD(1); SBAR(); GAPA(C0=__builtin_amdgcn_mfma_f32_32x32x16_bf16(kf[2],qr[1],C0,0,0,0),   PR2(P0,10),PR2(P0,12), pw1[0]=PKW(P0,8), pw1[1]=PKW(P0,10), pw1); \
    VRD(5); SBAR(); GAPA(C1=__builtin_amdgcn_mfma_f32_32x32x16_bf16(kf[3],qr[1],C1,0,0,0),   PR2(P0,14),PR2(P1,0),   pw1[2]=PKW(P0,12),pw1[3]=PKW(P0,14), pw1); \
    VRD(2); SBAR(); GAPA(C0=__builtin_amdgcn_mfma_f32_32x32x16_bf16(kf[4],qr[2],C0,0,0,0),   PR2(P1,2),PR2(P1,4),     pw2[0]=PKW(P1,0), pw2[1]=PKW(P1,2), pw2); \
    VRD(6); SBAR(); GAPA(C1=__builtin_amdgcn_mfma_f32_32x32x16_bf16(kf[5],qr[2],C1,0,0,0),   PR2(P1,6),PR2(P1,8),     pw2[2]=PKW(P1,4), pw2[3]=PKW(P1,6), pw2); \
    VRD(3); SBAR(); GAPA(C0=__builtin_amdgcn_mfma_f32_32x32x16_bf16(kf[6],qr[3],C0,0,0,0),   PR2(P1,10),PR2(P1,12), pw3[0]=PKW(P1,8), pw3[1]=PKW(P1,10), pw3); \
    VRD(7); SBAR(); GAPA1(C1=__builtin_amdgcn_mfma_f32_32x32x16_bf16(kf[7],qr[3],C1,0,0,0),   PR2(P1,14),       pw3[2]=PKW(P1,12),pw3[3]=PKW(P1,14), pw3); \
    l_reg+=sacc2[0]+sacc2[1]; \
    if(GK){DMA_K((t)+3,sl_cur);} if(GV){DMA_V((t)+1,sl_next);} \
    ADD32(C1); CMASK(C0,C1,t); \
    if(NOMAX){ resc=false; negm=negm+s64; asm volatile("":"+v"(negm)); } else \
    { float a=MX3(C0[0],C0[1],C1[0]),b=MX3(C0[2],C0[3],C1[1]); a=MX3(a,C1[2],C1[3]); \
      _Pragma("unroll") for(int r=4;r<16;r+=4){a=MX3(a,C0[r],C0[r+1]);b=MX3(b,C0[r+2],C0[r+3]);a=MX3(a,C1[r],C1[r+1]);b=MX3(b,C1[r+2],C1[r+3]);} \
      float rm=__builtin_fmaxf(a,b); { auto rr=__builtin_amdgcn_permlane32_swap(__float_as_uint(rm),__float_as_uint(rm),false,false); rm=__builtin_fmaxf(__uint_as_float(rr[0]),__uint_as_float(rr[1])); } \
      resc=false; \
      if(__builtin_expect(__any(rm>(float)THRL),0)){ const float dl=__builtin_fmaxf(rm,0.f); \
        _Pragma("unroll") for(int r=0;r<16;++r){C0[r]-=dl;C1[r]-=dl;} \
        negm=negm-dl; \
        const float f=__builtin_amdgcn_exp2f(-dl); l_reg*=f; if(hi==0)wsf[r32]=f; resc=true; } \
      negm=negm+s64; asm volatile("":"+v"(negm)); } \
    SBAR(); \
    GAPB(o[0]=__builtin_amdgcn_mfma_f32_32x32x16_bf16(PAF(0),VFR(0),o[0],0,0,0), C0,0); \
    GAPB(o[1]=__builtin_amdgcn_mfma_f32_32x32x16_bf16(PAF(0),VFR(4),o[1],0,0,0), C0,4); \
    KRD(GL,0); GAPB(o[0]=__builtin_amdgcn_mfma_f32_32x32x16_bf16(PAF(1),VFR(1),o[0],0,0,0), C0,8); \
    KRD(GL,1); GAPB(o[1]=__builtin_amdgcn_mfma_f32_32x32x16_bf16(PAF(1),VFR(5),o[1],0,0,0), C0,12); \
    KRD(GL,2); GAPB(o[0]=__builtin_amdgcn_mfma_f32_32x32x16_bf16(PAF(2),VFR(2),o[0],0,0,0), C1,0); \
    KRD(GL,3); GAPB(o[1]=__builtin_amdgcn_mfma_f32_32x32x16_bf16(PAF(2),VFR(6),o[1],0,0,0), C1,4); \
    GAPB(o[0]=__builtin_amdgcn_mfma_f32_32x32x16_bf16(PAF(3),VFR(3),o[0],0,0,0), C1,8); \
    GAPB(o[1]=__builtin_amdgcn_mfma_f32_32x32x16_bf16(PAF(3),VFR(7),o[1],0,0,0), C1,12); \
    }while(0)
  int t=1;
  #undef CMASK
  #define CMASK(P0,P1,t) do{}while(0)
  for(;t+5<NT;t+=2){
    STEP(pB0,pB1,pA0,pA1,t,true,true,true);     WAIT_BAR(2); RESC(); ROT();
    STEP(pA0,pA1,pB0,pB1,t+1,true,true,true);   WAIT_BAR(2); RESC(); ROT();
  }
  #undef CMASK
  #define CMASK(P0,P1,t) do{int jb_=(t)-(NT-4); if(jb_>=0)cmask(P0,P1,jb_,qrel,hi);}while(0)
  #define ENDW(tt) do{ if((tt)+3<NT){WAIT_BAR(2);} else if((tt)+2<NT){WAIT_BAR(1);} else {WAIT_BAR(0);} }while(0)
  for(;t+1<NT;t+=2){
    STEP(pB0,pB1,pA0,pA1,t,(t+3<NT),(t+1<NT),(t+1<NT));       ENDW(t);   RESC(); ROT();
    STEP(pA0,pA1,pB0,pB1,t+1,(t+4<NT),(t+2<NT),(t+2<NT));     ENDW(t+1); RESC(); ROT();
  }
  STEP(pB0,pB1,pA0,pA1,NT-1,false,false,false); RESC();
  { float sacc=pB0[0]+pB0[1]; _Pragma("unroll") for(int r=2;r<16;++r)sacc+=pB0[r]; _Pragma("unroll") for(int r=0;r<16;++r)sacc+=pB1[r]; l_reg+=sacc;
    pw0=(u32x4){PKW(pB0,0),PKW(pB0,2),PKW(pB0,4),PKW(pB0,6)};pw1=(u32x4){PKW(pB0,8),PKW(pB0,10),PKW(pB0,12),PKW(pB0,14)};pw2=(u32x4){PKW(pB1,0),PKW(pB1,2),PKW(pB1,4),PKW(pB1,6)};pw3=(u32x4){PKW(pB1,8),PKW(pB1,10),PKW(pB1,12),PKW(pB1,14)};
    SBAR(); pv(o,vb0+sl_cur,PAF(0),PAF(1),PAF(2),PAF(3)); }
  #undef PKW
  #undef PAF
  #undef VFR
  #undef PIN
  #undef MX3
  #undef GAPA
  #undef GAPA1
  #undef PR2
  #undef GAPB
  #undef EX
  #undef VRD
  #undef KRD
  #undef STEP
  #undef ENDW
  const int lane_e=lane, r32e=r32, hie=hi;
  {auto rr=__builtin_amdgcn_permlane32_swap(__float_as_uint(l_reg),__float_as_uint(l_reg),false,false);l_reg=__uint_as_float(rr[0])+__uint_as_float(rr[1]);}
  if(hie==0)wsf[32+r32e]=l_reg;asm volatile("s_waitcnt lgkmcnt(0)":::"memory");
  float rli[16];
  #pragma unroll
  for(int r=0;r<16;++r)rli[r]=__builtin_amdgcn_rcpf(wsf[32+crow(r,hie)]);
  bf16*Ow=O+(rowbase+q0+wid*QBLK)*PO+vh*D;
  { bf16*stg=(bf16*)(shm+LDS_OST)+wid*2048;
    #pragma unroll
    for(int r=0;r<16;++r){const int orow=crow(r,hie);
      #pragma unroll
      for(int d0=0;d0<2;++d0)stg[orow*64+d0*32+r32e]=__float2bfloat16(o[d0][r]*rli[r]);}
    asm volatile("s_waitcnt lgkmcnt(0)":::"memory");
    #pragma unroll
    for(int i=0;i<4;++i){const int row=i*8+(lane_e>>3),ch=lane_e&7; const u32x4 v=*(const u32x4*)(stg+row*64+ch*8); ATTN_STORE16(Ow+(long)row*PO+ch*8,v);} }
  asm volatile("s_waitcnt lgkmcnt(0)\n\ts_barrier":::"memory");
  #undef DMA_K
  #undef DMA_V
  #undef CMASK
  #undef START
  #undef RESC
  #undef ROT
  #undef SETC
  #undef ADD32
}

constexpr int W_LDS_K=0, W_VSLOT=16384, W_LDS_V=3*SLOTB, W_LDS_WS=W_LDS_V+3*W_VSLOT, W_LDS_OST=W_LDS_WS+NW*64*4, W_LDS_BYTES=W_LDS_OST+NW*4096;
__device__ __forceinline__ void attn_wide(int b,int hc,int qb,int split,const bf16*Q,const bf16*__restrict__ K,const bf16*__restrict__ V,bf16*P0,bf16*P1,float*L0,float*L1,char*shm,float smax2){
  const int tid=threadIdx.x,lane=tid&63,r32=lane&31,hi=lane>>5; const int wid=__builtin_amdgcn_readfirstlane(tid>>6);
  const int h=hc>>1; const long rowbase=(long)b*SEQ; const int q0=qb*QB;
  const float slope2=__builtin_ldexpf(1.4426950408889634f,-2*(h+1));
  int t0; { const float win=(150.f+smax2)/slope2; int tt=(int)floorf(((float)(q0-63)-win)*(1.f/64.f)); tt=tt<0?0:tt; tt&=~1; const int tmax=(q0+QB)/KVBLK-4; tt=tt>tmax?tmax:tt; t0=__builtin_amdgcn_readfirstlane(tt); }
  const int NT0=(q0+QB)/KVBLK, NTt=NT0-t0;
  int ta=t0,tb=NT0; bool empty=false;
  if(NTt>64){ const int h0=(NTt>>1)&~1; if(split==0)tb=t0+h0; else ta=t0+h0; } else if(split==1) empty=true;
  bf16*Ow=(split==0?P0:P1)+(rowbase+q0+wid*QBLK)*PO+hc*128;
  float*Lw=(split==0?L0:L1)+(rowbase+q0+wid*QBLK)*8+hc;
  if(empty){
    #pragma unroll
    for(int i=0;i<8;++i){const int row=i*4+(lane>>4),ch=lane&15; *(u32x4*)(Ow+(long)row*PO+ch*8)=(u32x4){0u,0u,0u,0u};}
    if(hi==0)Lw[r32*8]=0.f;
    return; }
  const bf16*Qw=Q+(rowbase+q0+wid*QBLK)*DM+hc*64;
  const bf16*Kh=K+rowbase*DM+hc*64,*Vh=V+rowbase*DM+h*128;
  const unsigned lds0=(unsigned)(uintptr_t)shm;
  float*wsf=(float*)(shm+W_LDS_WS)+wid*64;
  bf16x8 qr[4];
  #pragma unroll
  for(int d0=0;d0<4;++d0)qr[d0]=*reinterpret_cast<const bf16x8*>(&Qw[(long)r32*DM+d0*16+hi*8]);
  const unsigned koff_=(unsigned)(lane*DM*2), voff_=(unsigned)(((lane>>2)*DM+(lane&3)*8)*2);
  const char*kbase_=(const char*)(Kh+wid*8); const char*vbase_=(const char*)(Vh+(long)(16*(wid&3))*DM+(wid>>2)*32);
  const unsigned kdst=lds0+W_LDS_K+wid*1024, vdst=lds0+W_LDS_V+wid*1024;
  #define WDMA(t,sl) do{ glds16s(kbase_+(long)(t)*(KVBLK*DM*2),koff_,(unsigned)__builtin_amdgcn_readfirstlane(kdst+(sl)*SLOTB)); \
      glds16s(vbase_+(long)(t)*(KVBLK*DM*2),voff_,(unsigned)__builtin_amdgcn_readfirstlane(vdst+(sl)*W_VSLOT)); \
      glds16s(vbase_+(long)(t)*(KVBLK*DM*2)+128,voff_,(unsigned)__builtin_amdgcn_readfirstlane(vdst+(sl)*W_VSLOT+8192)); }while(0)
  const int vb0=(int)(lds0+W_LDS_V)+((lane>>4)&1)*32+(lane&3)*8+(4*hi+((lane&15)>>2))*64;
  const int qrel=wid*QBLK+r32;
  const unsigned esh_=(unsigned)(2*(h+1))<<23;
  #define SLC(c) ((c)==0?0.f:__uint_as_float(__float_as_uint(1.4426950408889634f*(float)(c))-esh_))
  f32x16 cini; { const float cb=slope2*(float)(KVBLK*ta+4*hi-q0-qrel);
    #pragma unroll
    for(int r=0;r<16;++r)cini[r]=cb+SLC((r&3)+8*(r>>2)); }
  const float s32=SLC(32), s64=SLC(64);
  f32x16 o[4]; o[0]=f32x16{};o[1]=f32x16{};o[2]=f32x16{};o[3]=f32x16{}; float l_reg=0.f;
  WDMA(ta,0); if(ta+1<tb){WDMA(ta+1,1);}
  int sl=0,sl2=2;
  for(int t=ta;t<tb;++t){
    if(t+1<tb){ asm volatile("s_waitcnt vmcnt(3) lgkmcnt(0)\n\ts_barrier":::"memory"); } else { asm volatile("s_waitcnt vmcnt(0) lgkmcnt(0)\n\ts_barrier":::"memory"); }
    if(t+2<tb){WDMA(t+2,sl2);}
    f32x16 p0,p1;
    qkt(p0,p1,shm+W_LDS_K+sl*SLOTB,qr,cini,r32,hi);
    #pragma unroll
    for(int r=0;r<16;++r)p1[r]+=s32;
    { const int jb_=t-(NT0-4); if(jb_>=0)cmask(p0,p1,jb_,qrel,hi); }
    #pragma unroll
    for(int r=0;r<16;++r){p0[r]=__builtin_amdgcn_exp2f(p0[r]);p1[r]=__builtin_amdgcn_exp2f(p1[r]);}
    { f32x2_t sa=(f32x2_t){p0[0],p0[1]}, sb=(f32x2_t){p1[0],p1[1]};
      #pragma unroll
      for(int r=2;r<16;r+=2){ sa+=(f32x2_t){p0[r],p0[r+1]}; sb+=(f32x2_t){p1[r],p1[r+1]}; }
      l_reg+=(sa[0]+sa[1])+(sb[0]+sb[1]); }
    u32x4 pw0,pw1,pw2,pw3;
    pw0=(u32x4){cvtpk_s(p0[0],p0[1]),cvtpk_s(p0[2],p0[3]),cvtpk_s(p0[4],p0[5]),cvtpk_s(p0[6],p0[7])}; pw1=(u32x4){cvtpk_s(p0[8],p0[9]),cvtpk_s(p0[10],p0[11]),cvtpk_s(p0[12],p0[13]),cvtpk_s(p0[14],p0[15])};
    pw2=(u32x4){cvtpk_s(p1[0],p1[1]),cvtpk_s(p1[2],p1[3]),cvtpk_s(p1[4],p1[5]),cvtpk_s(p1[6],p1[7])}; pw3=(u32x4){cvtpk_s(p1[8],p1[9]),cvtpk_s(p1[10],p1[11]),cvtpk_s(p1[12],p1[13]),cvtpk_s(p1[14],p1[15])};
    pv(o,  vb0+sl*W_VSLOT,     __builtin_bit_cast(bf16x8,pw0),__builtin_bit_cast(bf16x8,pw1),__builtin_bit_cast(bf16x8,pw2),__builtin_bit_cast(bf16x8,pw3));
    pv(o+2,vb0+sl*W_VSLOT+8192,__builtin_bit_cast(bf16x8,pw0),__builtin_bit_cast(bf16x8,pw1),__builtin_bit_cast(bf16x8,pw2),__builtin_bit_cast(bf16x8,pw3));
    cini=cini+s64;
    sl=(sl==2)?0:sl+1; sl2=(sl2==2)?0:sl2+1;
  }
  {auto rr=__builtin_amdgcn_permlane32_swap(__float_as_uint(l_reg),__float_as_uint(l_reg),false,false);l_reg=__uint_as_float(rr[0])+__uint_as_float(rr[1]);}
  if(hi==0)Lw[r32*8]=l_reg;
  bf16*stg=(bf16*)(shm+W_LDS_OST)+wid*2048;
  #pragma unroll
  for(int hf=0;hf<2;++hf){
    #pragma unroll
    for(int r=0;r<16;++r){const int orow=crow(r,hi);
      #pragma unroll
      for(int d0=0;d0<2;++d0)stg[orow*64+d0*32+r32]=__float2bfloat16(o[hf*2+d0][r]);}
    asm volatile("s_waitcnt lgkmcnt(0)":::"memory");
    #pragma unroll
    for(int i=0;i<4;++i){const int row=i*8+(lane>>3),ch=lane&7; const u32x4 v=*(const u32x4*)(stg+row*64+ch*8); *(u32x4*)(Ow+(long)row*PO+hf*64+ch*8)=v;}
    asm volatile("s_waitcnt lgkmcnt(0)":::"memory");
  }
  asm volatile("s_waitcnt lgkmcnt(0)\n\ts_barrier":::"memory");
  #undef WDMA
  #undef SLC
}

constexpr int X_NS=4, X_LDS_K=0, X_VSLOT=16384, X_LDS_V=X_NS*SLOTB, X_LDS_WS=X_LDS_V+X_NS*X_VSLOT, X_LDS_BYTES=X_LDS_WS+NW*64*4;
__device__ __forceinline__ int wide_t0(int q0,int h,float smax2){
  const float slope2=__builtin_ldexpf(1.4426950408889634f,-2*(h+1));
  const float win=(150.f+smax2)/slope2; int tt=(int)floorf(((float)(q0-63)-win)*(1.f/64.f)); tt=tt<0?0:tt; tt&=~1; const int tmax=(q0+QB)/KVBLK-4; return tt>tmax?tmax:tt; }
__device__ __forceinline__ bool wide_cut(int q0,int h,float smax2){ return (q0+QB)/KVBLK-wide_t0(q0,h,smax2)>64; }
__device__ __forceinline__ void attn_wide2(int b,int hc,int qb,int split,const bf16*Q,const bf16*__restrict__ K,const bf16*__restrict__ V,bf16*P0,bf16*P1,float*L0,float*L1,char*shm,float smax2){
  const int tid=threadIdx.x,lane=tid&63,r32=lane&31,hi=lane>>5; const int wid=__builtin_amdgcn_readfirstlane(tid>>6);
  const int h=hc>>1; const long rowbase=(long)b*SEQ; const int q0=qb*QB;
  const float slope2=__builtin_ldexpf(1.4426950408889634f,-2*(h+1));
  int t0; { const float win=(150.f+smax2)/slope2; int tt=(int)floorf(((float)(q0-63)-win)*(1.f/64.f)); tt=tt<0?0:tt; tt&=~1; const int tmax=(q0+QB)/KVBLK-4; tt=tt>tmax?tmax:tt; t0=__builtin_amdgcn_readfirstlane(tt); }
  const int NT0=(q0+QB)/KVBLK, NTt=NT0-t0;
  int ta=t0,tb=NT0; bool empty=false;
  if(NTt>64){ const int h0=(NTt>>1)&~1; if(split==0)tb=t0+h0; else ta=t0+h0; } else if(split==1) empty=true;
  bf16*Ow=(split==0?P0:P1)+(rowbase+q0+wid*QBLK)*PO+hc*128;
  float*Lw=(split==0?L0:L1)+(rowbase+q0+wid*QBLK)*8+hc;
  if(empty)return;
  const bf16*Qw=Q+(rowbase+q0+wid*QBLK)*DM+hc*64;
  const bf16*Kh=K+rowbase*DM+hc*64,*Vh=V+rowbase*DM+h*128;
  const unsigned lds0=(unsigned)(uintptr_t)shm;
  bf16x8 qr[4];
  #pragma unroll
  for(int d0=0;d0<4;++d0)qr[d0]=*reinterpret_cast<const bf16x8*>(&Qw[(long)r32*DM+d0*16+hi*8]);
  const unsigned koff_=(unsigned)(lane*DM*2), voff_=(unsigned)(((lane>>2)*DM+(lane&3)*8)*2);
  const char*kbase_=(const char*)(Kh+wid*8); const char*vbase_=(const char*)(Vh+(long)(16*(wid&3))*DM+(wid>>2)*32);
  const unsigned kdst=lds0+X_LDS_K+wid*1024, vdst=lds0+X_LDS_V+wid*1024;
  #define XDMA(t,sl) do{ glds16s(kbase_+(long)(t)*(KVBLK*DM*2),koff_,(unsigned)__builtin_amdgcn_readfirstlane(kdst+(sl)*SLOTB)); \
      glds16s(vbase_+(long)(t)*(KVBLK*DM*2),voff_,(unsigned)__builtin_amdgcn_readfirstlane(vdst+(sl)*X_VSLOT)); \
      glds16s(vbase_+(long)(t)*(KVBLK*DM*2)+128,voff_,(unsigned)__builtin_amdgcn_readfirstlane(vdst+(sl)*X_VSLOT+8192)); }while(0)
  const lds_cptr shm3=(lds_cptr)shm; const lds_cptr vp0=shm3+X_LDS_V+((lane>>4)&1)*32+(lane&3)*8+(4*hi+((lane&15)>>2))*64;
  const int qrel=wid*QBLK+r32;
  const unsigned esh_=(unsigned)(2*(h+1))<<23;
  #define SLC(c) ((c)==0?0.f:__uint_as_float(__float_as_uint(1.4426950408889634f*(float)(c))-esh_))
  f32x16 cini; { const float cb=slope2*(float)(KVBLK*ta+4*hi-q0-qrel);
    #pragma unroll
    for(int r=0;r<16;++r)cini[r]=cb+SLC((r&3)+8*(r>>2)); }
  const float s32=SLC(32), s64=SLC(64);
  f32x16 o[4]; o[0]=f32x16{};o[1]=f32x16{};o[2]=f32x16{};o[3]=f32x16{}; float l_reg=0.f;
  const int nt=tb-ta;
  XDMA(ta,0); if(nt>1){XDMA(ta+1,1);} if(nt>2){XDMA(ta+2,2);}
  if(nt>2){ asm volatile("s_waitcnt vmcnt(6) lgkmcnt(0)\n\ts_barrier":::"memory"); } else if(nt>1){ asm volatile("s_waitcnt vmcnt(3) lgkmcnt(0)\n\ts_barrier":::"memory"); } else { asm volatile("s_waitcnt vmcnt(0) lgkmcnt(0)\n\ts_barrier":::"memory"); }
  f32x16 pC0,pC1;
  qkt(pC0,pC1,shm+X_LDS_K,qr,cini,r32,hi); cini=cini+s64;
  int sl=0;
  #define EX4(P,B) do{ P[B]=__builtin_amdgcn_exp2f(P[B]); P[B+1]=__builtin_amdgcn_exp2f(P[B+1]); P[B+2]=__builtin_amdgcn_exp2f(P[B+2]); P[B+3]=__builtin_amdgcn_exp2f(P[B+3]); }while(0)
  #define VF(L,H,i) (bf16x8){L[i][0],L[i][1],L[i][2],L[i][3],H[i][0],H[i][1],H[i][2],H[i][3]}
  #define RELD(i) do{ al[i]=vtr(vp_+(8192+((i)>>2)*4096+((i)&3)*1024)); ah[i]=vtr(vp_+(8192+((i)>>2)*4096+((i)&3)*1024+512)); }while(0)
  #define WSTEP(C0_,C1_,N0_,N1_,T_) do{ \
    _Pragma("unroll") \
    for(int r=0;r<16;++r)C1_[r]+=s32; \
    { const int jb_=T_-(NT0-4); if(jb_>=0)cmask(C0_,C1_,jb_,qrel,hi); } \
    if(T_+2<tb){ asm volatile("s_waitcnt vmcnt(3) lgkmcnt(0)\n\ts_barrier":::"memory"); } else { asm volatile("s_waitcnt vmcnt(0) lgkmcnt(0)\n\ts_barrier":::"memory"); } \
    if(T_+3<tb){XDMA(T_+3,(sl+3)&3);} \
    if(T_+1<tb){ \
      const char*kb=shm+X_LDS_K+((sl+1)&3)*SLOTB+hi*1024+r32*16; \
      bf16x8 k0=*reinterpret_cast<const bf16x8*>(kb), k1=*reinterpret_cast<const bf16x8*>(kb+512); \
      _Pragma("unroll") \
      for(int d0=0;d0<4;++d0){ \
        bf16x8 n0=k0,n1=k1; if(d0<3){ n0=*reinterpret_cast<const bf16x8*>(kb+(d0+1)*2048); n1=*reinterpret_cast<const bf16x8*>(kb+(d0+1)*2048+512); } \
        if(d0==0)N0_=__builtin_amdgcn_mfma_f32_32x32x16_bf16(k0,qr[0],cini,0,0,0); else N0_=__builtin_amdgcn_mfma_f32_32x32x16_bf16(k0,qr[d0],N0_,0,0,0); \
        EX4(C0_,4*d0); SBAR(); \
        if(d0==0)N1_=__builtin_amdgcn_mfma_f32_32x32x16_bf16(k1,qr[0],cini,0,0,0); else N1_=__builtin_amdgcn_mfma_f32_32x32x16_bf16(k1,qr[d0],N1_,0,0,0); \
        EX4(C1_,4*d0); SBAR(); \
        k0=n0;k1=n1; } \
      cini=cini+s64; \
    } else { \
      _Pragma("unroll") \
      for(int d0=0;d0<4;++d0){EX4(C0_,4*d0);EX4(C1_,4*d0);} \
    } \
    if(!((T_-(NT0-4)>=1)&&(2*(T_-(NT0-4))>wid))){ \
    const lds_cptr vp_=vp0+sl*X_VSLOT; \
    s16x4 al[8],ah[8]; \
    _Pragma("unroll") \
    for(int i=0;i<8;++i){ al[i]=vtr(vp_+((i>>2)*4096+(i&3)*1024)); ah[i]=vtr(vp_+((i>>2)*4096+(i&3)*1024+512)); } \
    { f32x2_t sa=(f32x2_t){C0_[0],C0_[1]}, sb=(f32x2_t){C1_[0],C1_[1]}; \
      _Pragma("unroll") \
      for(int r=2;r<16;r+=2){ sa+=(f32x2_t){C0_[r],C0_[r+1]}; sb+=(f32x2_t){C1_[r],C1_[r+1]}; } \
      l_reg+=(sa[0]+sa[1])+(sb[0]+sb[1]); } \
    u32x4 pw0,pw1,pw2,pw3; \
    pw0=(u32x4){cvtpk_s(C0_[0],C0_[1]),cvtpk_s(C0_[2],C0_[3]),cvtpk_s(C0_[4],C0_[5]),cvtpk_s(C0_[6],C0_[7])}; pw1=(u32x4){cvtpk_s(C0_[8],C0_[9]),cvtpk_s(C0_[10],C0_[11]),cvtpk_s(C0_[12],C0_[13]),cvtpk_s(C0_[14],C0_[15])}; \
    pw2=(u32x4){cvtpk_s(C1_[0],C1_[1]),cvtpk_s(C1_[2],C1_[3]),cvtpk_s(C1_[4],C1_[5]),cvtpk_s(C1_[6],C1_[7])}; pw3=(u32x4){cvtpk_s(C1_[8],C1_[9]),cvtpk_s(C1_[10],C1_[11]),cvtpk_s(C1_[12],C1_[13]),cvtpk_s(C1_[14],C1_[15])}; \
    const bf16x8 pa0=__builtin_bit_cast(bf16x8,pw0),pa1=__builtin_bit_cast(bf16x8,pw1),pa2=__builtin_bit_cast(bf16x8,pw2),pa3=__builtin_bit_cast(bf16x8,pw3); \
    SBAR(); \
    o[0]=__builtin_amdgcn_mfma_f32_32x32x16_bf16(pa0,VF(al,ah,0),o[0],0,0,0); o[1]=__builtin_amdgcn_mfma_f32_32x32x16_bf16(pa0,VF(al,ah,4),o[1],0,0,0); \
    RELD(0); RELD(4); \
    o[0]=__builtin_amdgcn_mfma_f32_32x32x16_bf16(pa1,VF(al,ah,1),o[0],0,0,0); o[1]=__builtin_amdgcn_mfma_f32_32x32x16_bf16(pa1,VF(al,ah,5),o[1],0,0,0); \
    RELD(1); RELD(5); \
    o[0]=__builtin_amdgcn_mfma_f32_32x32x16_bf16(pa2,VF(al,ah,2),o[0],0,0,0); o[1]=__builtin_amdgcn_mfma_f32_32x32x16_bf16(pa2,VF(al,ah,6),o[1],0,0,0); \
    RELD(2); RELD(6); \
    o[0]=__builtin_amdgcn_mfma_f32_32x32x16_bf16(pa3,VF(al,ah,3),o[0],0,0,0); o[1]=__builtin_amdgcn_mfma_f32_32x32x16_bf16(pa3,VF(al,ah,7),o[1],0,0,0); \
    RELD(3); RELD(7); \
    o[2]=__builtin_amdgcn_mfma_f32_32x32x16_bf16(pa0,VF(al,ah,0),o[2],0,0,0); o[3]=__builtin_amdgcn_mfma_f32_32x32x16_bf16(pa0,VF(al,ah,4),o[3],0,0,0); \
    o[2]=__builtin_amdgcn_mfma_f32_32x32x16_bf16(pa1,VF(al,ah,1),o[2],0,0,0); o[3]=__builtin_amdgcn_mfma_f32_32x32x16_bf16(pa1,VF(al,ah,5),o[3],0,0,0); \
    o[2]=__builtin_amdgcn_mfma_f32_32x32x16_bf16(pa2,VF(al,ah,2),o[2],0,0,0); o[3]=__builtin_amdgcn_mfma_f32_32x32x16_bf16(pa2,VF(al,ah,6),o[3],0,0,0); \
    o[2]=__builtin_amdgcn_mfma_f32_32x32x16_bf16(pa3,VF(al,ah,3),o[2],0,0,0); o[3]=__builtin_amdgcn_mfma_f32_32x32x16_bf16(pa3,VF(al,ah,7),o[3],0,0,0); } \
    sl=(sl+1)&3; \
  }while(0)
  f32x16 pD0,pD1;
  for(int t=ta;t<tb;t+=2){ WSTEP(pC0,pC1,pD0,pD1,t); WSTEP(pD0,pD1,pC0,pC1,t+1); }
  #undef WSTEP
  #undef RELD
  {auto rr=__builtin_amdgcn_permlane32_swap(__float_as_uint(l_reg),__float_as_uint(l_reg),false,false);l_reg=__uint_as_float(rr[0])+__uint_as_float(rr[1]);}
  { int r32e=r32; asm volatile("":"+v"(r32e)); if(hi==0)Lw[r32e*8]=l_reg; }
  asm volatile("s_waitcnt lgkmcnt(0)\n\ts_barrier":::"memory");
  bf16*stg=(bf16*)(shm+X_LDS_K)+wid*2048;
  #pragma unroll
  for(int hf=0;hf<2;++hf){
    #pragma unroll
    for(int r=0;r<16;++r){const int orow=crow(r,hi);
      #pragma unroll
      for(int d0=0;d0<2;++d0)stg[orow*64+d0*32+r32]=__float2bfloat16(o[hf*2+d0][r]);}
    asm volatile("s_waitcnt lgkmcnt(0)":::"memory");
    #pragma unroll
    for(int i=0;i<4;++i){const int row=i*8+(lane>>3),ch=lane&7; const u32x4 v=*(const u32x4*)(stg+row*64+ch*8); *(u32x4*)(Ow+(long)row*PO+hf*64+ch*8)=v;}
    asm volatile("s_waitcnt lgkmcnt(0)":::"memory");
  }
  asm volatile("s_waitcnt lgkmcnt(0)\n\ts_barrier":::"memory");
  #undef XDMA
  #undef EX4
  #undef VF
}
constexpr int ATTN_LDS_BYTES=LDS_BYTES;
struct AttnTensors { const bf16* Q; const bf16* K; const bf16* V; bf16* O; float smax2; };
struct AttnUnit { int bh; int qb; };
struct StaticOrder {
  int vcu;
  __device__ __forceinline__ explicit StaticOrder(int grid,int block):vcu((block%8)*(grid/8)+block/8){}
  __device__ __forceinline__ bool next(int i,AttnUnit&u)const{ if(i>=4)return false; const int s=vcu&7; u.bh=vcu>>3; u.qb=(i==0)?s:(i==1)?15-s:(i==2)?16+s:31-s; return true; }
  __device__ __forceinline__ void a_ready(const AttnUnit&)const{}
  __device__ __forceinline__ void done(const AttnUnit&)const{}
};
template<class Sched,int THRL=8> __device__ __forceinline__ void attn_phase(char*lds,const AttnTensors&T,const Sched&S){
  AttnUnit u;
  for(int i=0;S.next(i,u);++i){ S.a_ready(u); attn_unit<THRL>(u.bh/NHEAD,u.bh%NHEAD,u.qb,T.Q,T.K,T.V,T.O,lds,T.smax2,false); S.done(u); }
}
#undef SBAR
#undef WAIT_BAR
}
namespace cg = cooperative_groups;
constexpr int NWAVES = 8;
constexpr int M = 16384, D = 1024, FF = 4096, NIN = 4096, SEQ = 8192;
constexpr float EPS = 1e-6f, ONE_MINUS_LINIT = 0.8f, LAMBDA_INIT = 0.2f;
#ifndef MK_N_LAUNCHES
#define MK_N_LAUNCHES 1
#endif
constexpr int N_PHASES = 8;
constexpr size_t MiB = 1u << 20;
constexpr size_t WS_BAR = 4096, WS_CTL_BYTES = 32768;
constexpr size_t WS_CTR = 0;
constexpr size_t WS_WIN = 2 * MiB, WS_WA = 10 * MiB, WS_WB = 11 * MiB, WS_WOUT = 12 * MiB, WS_W1 = 14 * MiB, WS_W2 = 22 * MiB;
constexpr size_t WS_SSQ = 30 * MiB;
constexpr size_t WS_L0 = 31 * MiB, WS_L1 = 31 * MiB + 512 * 1024;
constexpr size_t WS_P1 = 160 * MiB;
constexpr size_t WS_XN = 32 * MiB;
constexpr size_t WS_OV = 32 * MiB;
constexpr size_t WS_MG = 32 * MiB;
constexpr size_t WS_G = 64 * MiB;
constexpr size_t WS_PL = 128 * MiB, WS_ON = 144 * MiB;
constexpr size_t WS_H = 32 * MiB;
constexpr size_t WS_X1B = 160 * MiB;
constexpr size_t WS_Q = 192 * MiB, WS_K = 208 * MiB, WS_V = 224 * MiB, WS_U = 240 * MiB;
constexpr size_t WS_T1 = 192 * MiB;
constexpr size_t WS_END = 256 * MiB;
constexpr int RING_BYTES = 131072, LDS_BYTES = 147456;

#define GAS __attribute__((address_space(1)))
#define LAS __attribute__((address_space(3)))
typedef unsigned short bf16;
typedef unsigned v4u __attribute__((ext_vector_type(4)));
typedef float f32x4 __attribute__((ext_vector_type(4)));
#define LDS_WAIT() asm volatile("s_waitcnt lgkmcnt(0)" ::: "memory")
#define VM_WAIT() asm volatile("s_waitcnt vmcnt(0)" ::: "memory")
__device__ __forceinline__ unsigned f2bf(float f) { unsigned u = __builtin_bit_cast(unsigned, f); return (u + 0x7fffu + ((u >> 16) & 1u)) >> 16; }
__device__ __forceinline__ unsigned pk2(float lo, float hi) { return f2bf(lo) | (f2bf(hi) << 16); }
__device__ __forceinline__ float bflo(unsigned w) { return __uint_as_float(w << 16); }
__device__ __forceinline__ float bfhi(unsigned w) { return __uint_as_float(w & 0xffff0000u); }
__device__ __forceinline__ float wave_sum(float v) {
#pragma unroll
    for (int o = 1; o < 64; o <<= 1) v += __shfl_xor(v, o);
    return v;
}
__device__ __forceinline__ void p0_transpose_item(const float* W, int K, int N, bf16* WT, int ldw, bool permn, const float* rs, int rsmask, float rsmul, LAS float* scr, int item, int lane) {
    const int nblk = N / 32, kb = item / nblk, nb = item % nblk, k0 = 64 * kb, n0 = 32 * nb;
    float wv[32];
#pragma unroll
    for (int i = 0; i < 32; ++i) { const int kk = 2 * i + (lane >> 5); wv[i] = W[(size_t)(k0 + kk) * N + n0 + (lane & 31)]; }
    if (rs) {
#pragma unroll
        for (int i = 0; i < 32; ++i) { const int kk = 2 * i + (lane >> 5); wv[i] *= rs[(k0 + kk) & rsmask] * rsmul; } }
#pragma unroll
    for (int i = 0; i < 32; ++i) { const int kk = 2 * i + (lane >> 5); scr[kk * 33 + (lane & 31)] = wv[i]; }
    LDS_WAIT(); asm volatile("" ::: "memory");
    int n0p = n0; if (permn) { const int ga = (n0 >> 5) & 7; n0p = (n0 & ~255) + 32 * (((ga & 1) << 2) | (ga >> 1)); }
    const int c = lane & 7;
#pragma unroll
    for (int j = 0; j < 4; ++j) { const int n = (lane >> 3) + 8 * j; const LAS float* s = scr + (8 * c) * 33 + n;
        v4u o; o.x = pk2(s[0 * 33], s[1 * 33]); o.y = pk2(s[2 * 33], s[3 * 33]); o.z = pk2(s[4 * 33], s[5 * 33]); o.w = pk2(s[6 * 33], s[7 * 33]);
        *(GAS v4u*)(WT + (size_t)(n0p + n) * ldw + k0 + 8 * c) = o; }
    LDS_WAIT(); asm volatile("" ::: "memory");
}
__device__ __forceinline__ void p0_transpose_item_rt(const float* W, int K, int lgnb, bf16* WT, int ldw, bool has_rs, const float* rs, int rsmask, float rsmul, LAS float* scr, int item, int lane) {
    const int N = 32 << lgnb, kb = item >> lgnb, nb = item & ((1 << lgnb) - 1), k0 = 64 * kb, n0 = 32 * nb;
    float wv[32];
#pragma unroll
    for (int i = 0; i < 32; ++i) { const int kk = 2 * i + (lane >> 5); wv[i] = W[(size_t)(k0 + kk) * N + n0 + (lane & 31)]; }
    if (has_rs) {
#pragma unroll
        for (int i = 0; i < 32; ++i) { const int kk = 2 * i + (lane >> 5); wv[i] *= rs[(k0 + kk) & rsmask] * rsmul; } }
#pragma unroll
    for (int i = 0; i < 32; ++i) { const int kk = 2 * i + (lane >> 5); scr[kk * 33 + (lane & 31)] = wv[i]; }
    LDS_WAIT(); asm volatile("" ::: "memory");
    const int c = lane & 7;
#pragma unroll
    for (int j = 0; j < 4; ++j) { const int n = (lane >> 3) + 8 * j; const LAS float* s = scr + (8 * c) * 33 + n;
        v4u o; o.x = pk2(s[0 * 33], s[1 * 33]); o.y = pk2(s[2 * 33], s[3 * 33]); o.z = pk2(s[4 * 33], s[5 * 33]); o.w = pk2(s[6 * 33], s[7 * 33]);
        *(GAS v4u*)(WT + (size_t)(n0 + n) * ldw + k0 + 8 * c) = o; }
    LDS_WAIT(); asm volatile("" ::: "memory");
}
__device__ __forceinline__ void p0_fold_a_wg(const float* pool_w, const float* pool_scale, const float* wba, bf16* WAt, int item, LAS unsigned char* ldsp, int wave, int lane) {
    const int g = item >> 6, n0 = (item & 63) * 16;
    LAS float* wbs = (LAS float*)ldsp; LAS float* pws = (LAS float*)(ldsp + 8192);
    { float v[4];
#pragma unroll
      for (int i = 0; i < 4; ++i) { const int d = wave * 16 + i * 4 + (lane >> 4); v[i] = pool_scale[g * 128 + d] * wba[(size_t)(g * 128 + d) * 1024 + n0 + (lane & 15)]; }
      f32x4 p[8];
#pragma unroll
      for (int i = 0; i < 8; ++i) p[i] = *(const f32x4*)(pool_w + (size_t)g * 16384 + (size_t)wave * 2048 + i * 256 + lane * 4);
#pragma unroll
      for (int i = 0; i < 4; ++i) wbs[(wave * 16 + i * 4 + (lane >> 4)) * 16 + (lane & 15)] = v[i];
#pragma unroll
      for (int i = 0; i < 8; ++i) *(LAS f32x4*)(pws + wave * 2048 + i * 256 + lane * 4) = p[i]; }
    LDS_WAIT(); __syncthreads();
    { const int c0 = wave * 16 + (lane >> 4) * 4, n = lane & 15;
      float o[4] = {0.f, 0.f, 0.f, 0.f};
#pragma unroll 4
      for (int d = 0; d < 128; d += 4) {
          float w[4];
#pragma unroll
          for (int e = 0; e < 4; ++e) w[e] = wbs[(d + e) * 16 + n];
#pragma unroll
          for (int j = 0; j < 4; ++j) { const f32x4 p = *(const LAS f32x4*)(pws + (c0 + j) * 128 + d); o[j] += (p[0] * w[0] + p[1] * w[1]) + (p[2] * w[2] + p[3] * w[3]); }
      }
      *(GAS unsigned long long*)(WAt + (size_t)(n0 + n) * 1024 + g * 128 + c0) = (unsigned long long)pk2(o[0], o[1]) | ((unsigned long long)pk2(o[2], o[3]) << 32); }
    LDS_WAIT(); __syncthreads();
}
template <int R> __device__ __forceinline__ void rms_rows_to_bf16(const float* x, const float* g, bf16* o, int m0, int stride, int lane) {
    f32x4 v[R][4]; float s[R];
#pragma unroll
    for (int i = 0; i < R; ++i) { const GAS f32x4* xr = (const GAS f32x4*)(x + (size_t)(m0 + i * stride) * D) + lane;
#pragma unroll
        for (int j = 0; j < 4; ++j) v[i][j] = xr[64 * j]; }
    f32x4 gg[4];
#pragma unroll
    for (int j = 0; j < 4; ++j) gg[j] = ((const GAS f32x4*)g + lane)[64 * j];
#pragma unroll
    for (int i = 0; i < R; ++i) { s[i] = 0.f;
#pragma unroll
        for (int j = 0; j < 4; ++j) s[i] += (v[i][j].x * v[i][j].x + v[i][j].y * v[i][j].y) + (v[i][j].z * v[i][j].z + v[i][j].w * v[i][j].w); }
#pragma unroll
    for (int of = 1; of < 64; of <<= 1) {
#pragma unroll
        for (int i = 0; i < R; ++i) s[i] += __shfl_xor(s[i], of); }
#pragma unroll
    for (int i = 0; i < R; ++i) { const float r = 1.0f / sqrtf(s[i] * (1.0f / D) + EPS);
        GAS unsigned long long* o8 = (GAS unsigned long long*)(o + (size_t)(m0 + i * stride) * D) + lane;
#pragma unroll
        for (int j = 0; j < 4; ++j) o8[64 * j] = (unsigned long long)pk2(v[i][j].x * r * gg[j].x, v[i][j].y * r * gg[j].y) | ((unsigned long long)pk2(v[i][j].z * r * gg[j].z, v[i][j].w * r * gg[j].w) << 32); }
}
__device__ __forceinline__ void pool_row(const bf16* U, bf16* PL, int m, int lane) {
    const int t = m & (SEQ - 1), w = 2 << (lane >> 4), cnt = (t + 1 < w) ? (t + 1) : w;
    const GAS v4u* up = (const GAS v4u*)(U + (size_t)m * 512) + lane;
    float s[8], x0[8];
    { const v4u q = up[0]; x0[0] = bflo(q.x); x0[1] = bfhi(q.x); x0[2] = bflo(q.y); x0[3] = bfhi(q.y); x0[4] = bflo(q.z); x0[5] = bfhi(q.z); x0[6] = bflo(q.w); x0[7] = bfhi(q.w); }
#pragma unroll
    for (int e = 0; e < 8; ++e) s[e] = x0[e];
    v4u qv[15];
#pragma unroll
    for (int i = 1; i < 16; ++i) qv[i - 1] = up[(i < cnt) ? -64 * i : 0];
#pragma unroll
    for (int i = 1; i < 16; ++i) { const v4u q = qv[i - 1]; const float mk = (i < cnt) ? 1.0f : 0.0f;
        s[0] += mk * bflo(q.x); s[1] += mk * bfhi(q.x); s[2] += mk * bflo(q.y); s[3] += mk * bfhi(q.y); s[4] += mk * bflo(q.z); s[5] += mk * bfhi(q.z); s[6] += mk * bflo(q.w); s[7] += mk * bfhi(q.w); }
    const float ic = 1.0f / (float)cnt;
    v4u o; o.x = pk2(s[0] * ic - x0[0], s[1] * ic - x0[1]); o.y = pk2(s[2] * ic - x0[2], s[3] * ic - x0[3]); o.z = pk2(s[4] * ic - x0[4], s[5] * ic - x0[5]); o.w = pk2(s[6] * ic - x0[6], s[7] * ic - x0[7]);
    *((GAS v4u*)(PL + (size_t)m * 1024) + lane) = o;
}
__device__ __forceinline__ void combine_row(const bf16* OV, bf16* ON, int m, float lam, int lane) {
    const int h = lane >> 4, j8 = (lane & 15) * 8;
    const v4u a = *(const GAS v4u*)(OV + (size_t)m * 1024 + h * 256 + j8), b = *(const GAS v4u*)(OV + (size_t)m * 1024 + h * 256 + 128 + j8);
    float d[8];
    d[0] = bflo(a.x) - lam * bflo(b.x); d[1] = bfhi(a.x) - lam * bfhi(b.x); d[2] = bflo(a.y) - lam * bflo(b.y); d[3] = bfhi(a.y) - lam * bfhi(b.y);
    d[4] = bflo(a.z) - lam * bflo(b.z); d[5] = bfhi(a.z) - lam * bfhi(b.z); d[6] = bflo(a.w) - lam * bflo(b.w); d[7] = bfhi(a.w) - lam * bfhi(b.w);
    float ss = 0.f;
#pragma unroll
    for (int e = 0; e < 8; ++e) ss += d[e] * d[e];
    ss += __shfl_xor(ss, 1); ss += __shfl_xor(ss, 2); ss += __shfl_xor(ss, 4); ss += __shfl_xor(ss, 8);
    const float r = 1.0f / sqrtf(ss * (1.0f / 128.0f) + EPS);
    v4u o; o.x = pk2(d[0] * r, d[1] * r); o.y = pk2(d[2] * r, d[3] * r); o.z = pk2(d[4] * r, d[5] * r); o.w = pk2(d[6] * r, d[7] * r);
    *(GAS v4u*)(ON + (size_t)m * 1024 + 512 + h * 128 + j8) = o;
}
template <int R> __device__ __forceinline__ void combine_wide(const bf16* P0, const bf16* P1, const float* L0, const float* L1, bf16* ON, int m0, int stride, float lam, float smax2, int lane) {
    const int h = lane >> 4, j8 = (lane & 15) * 8;
    v4u a0[R], a1[R], b0[R], b1[R]; float la[R], lb[R];
#pragma unroll
    for (int i = 0; i < R; ++i) { const size_t m = (size_t)(m0 + i * stride), o = m * 1024 + h * 256 + j8;
        const bool cut = attn_body::wide_cut((int)(m & (SEQ - 1)) & ~255, h, smax2);
        a0[i] = *(const GAS v4u*)(P0 + o); b0[i] = *(const GAS v4u*)(P0 + o + 128); la[i] = L0[m * 8 + h * 2]; lb[i] = L0[m * 8 + h * 2 + 1];
        a1[i] = (v4u){0u, 0u, 0u, 0u}; b1[i] = a1[i];
        if (cut) { a1[i] = *(const GAS v4u*)(P1 + o); b1[i] = *(const GAS v4u*)(P1 + o + 128); la[i] += L1[m * 8 + h * 2]; lb[i] += L1[m * 8 + h * 2 + 1]; } }
#pragma unroll
    for (int i = 0; i < R; ++i) {
        const float ia = 1.0f / la[i], ib = lam / lb[i];
        float d[8];
        d[0] = (bflo(a0[i].x) + bflo(a1[i].x)) * ia - (bflo(b0[i].x) + bflo(b1[i].x)) * ib; d[1] = (bfhi(a0[i].x) + bfhi(a1[i].x)) * ia - (bfhi(b0[i].x) + bfhi(b1[i].x)) * ib;
        d[2] = (bflo(a0[i].y) + bflo(a1[i].y)) * ia - (bflo(b0[i].y) + bflo(b1[i].y)) * ib; d[3] = (bfhi(a0[i].y) + bfhi(a1[i].y)) * ia - (bfhi(b0[i].y) + bfhi(b1[i].y)) * ib;
        d[4] = (bflo(a0[i].z) + bflo(a1[i].z)) * ia - (bflo(b0[i].z) + bflo(b1[i].z)) * ib; d[5] = (bfhi(a0[i].z) + bfhi(a1[i].z)) * ia - (bfhi(b0[i].z) + bfhi(b1[i].z)) * ib;
        d[6] = (bflo(a0[i].w) + bflo(a1[i].w)) * ia - (bflo(b0[i].w) + bflo(b1[i].w)) * ib; d[7] = (bfhi(a0[i].w) + bfhi(a1[i].w)) * ia - (bfhi(b0[i].w) + bfhi(b1[i].w)) * ib;
        float ss = 0.f;
#pragma unroll
        for (int e = 0; e < 8; ++e) ss += d[e] * d[e];
        ss += __shfl_xor(ss, 1); ss += __shfl_xor(ss, 2); ss += __shfl_xor(ss, 4); ss += __shfl_xor(ss, 8);
        const float r = 1.0f / sqrtf(ss * (1.0f / 128.0f) + EPS);
        v4u o; o.x = pk2(d[0] * r, d[1] * r); o.y = pk2(d[2] * r, d[3] * r); o.z = pk2(d[4] * r, d[5] * r); o.w = pk2(d[6] * r, d[7] * r);
        *(GAS v4u*)(ON + (size_t)(m0 + i * stride) * 1024 + 512 + h * 128 + j8) = o; }
}
#define XB_TMO      128
#define XB_XCNT(j)  (256  + 64 * (j))
#define XB_XSUB(j)  (1280 + 64 * (j))
#define XB_XGEN(j)  (2304 + 64 * (j))
#define XB_TOP      3328
#define XB_TOPGEN   3392
#define XCD_BAR_WORDS 3456
#define XB_SPIN_CAP (1u << 18)

__device__ __forceinline__ unsigned xb_ld(unsigned* p)              { return __hip_atomic_load(p, __ATOMIC_RELAXED, __HIP_MEMORY_SCOPE_AGENT); }
__device__ __forceinline__ unsigned xb_add(unsigned* p, unsigned v) { return __hip_atomic_fetch_add(p, v, __ATOMIC_RELAXED, __HIP_MEMORY_SCOPE_AGENT); }
__device__ __forceinline__ unsigned xb_xcc_id() { return (unsigned)__builtin_amdgcn_s_getreg((3 << 11) | 20) & 0xFu; }
#define XB_SPIN(cond, bar) do { unsigned _sp = 0; while (cond) { __builtin_amdgcn_s_sleep(1); \
    if ((++_sp & 255u) == 0u) { if (xb_ld(&(bar)[XB_TMO])) break; if (_sp > XB_SPIN_CAP) { atomicAdd(&(bar)[XB_TMO], 1u); break; } } } } while (0)

struct XcdBarrier {
    unsigned* bar; unsigned x;
    volatile LAS unsigned* st;
};

__device__ __forceinline__ XcdBarrier xcd_barrier_post(unsigned* bar, volatile LAS unsigned* st) {
    XcdBarrier b; b.bar = bar; b.x = xb_xcc_id(); b.st = st;
    if (threadIdx.x == 0) (void)xb_add(&bar[XB_XCNT(b.x)], 1u);
    return b;
}
__device__ __forceinline__ void xcd_barrier_complete(unsigned* bar, unsigned x, unsigned& nloc, unsigned& nx) {
    const unsigned G = gridDim.x * gridDim.y * gridDim.z;
    unsigned sum, cnt, mine, sp = 0u;
    for (;;) {
        sum = 0u; cnt = 0u; mine = 0u;
#pragma unroll
        for (unsigned j = 0; j < 16; ++j) { const unsigned c = xb_ld(&bar[XB_XCNT(j)]); sum += c; cnt += (c > 0u) ? 1u : 0u; mine = (j == x) ? c : mine; }
        if (sum == G) break;
        __builtin_amdgcn_s_sleep(1);
        if ((++sp & 255u) == 0u) { if (xb_ld(&bar[XB_TMO])) break; if (sp > XB_SPIN_CAP) { atomicAdd(&bar[XB_TMO], 1u); break; } }
    }
    nloc = mine > 0u ? mine : 1u; nx = cnt > 0u ? cnt : 1u;
}

__device__ __forceinline__ void xcd_barrier(const XcdBarrier& b) {
    asm volatile("s_waitcnt vmcnt(0)" ::: "memory");
    __syncthreads();
    if (threadIdx.x == 0) {
        unsigned* bar = b.bar;
        __builtin_amdgcn_s_waitcnt(0);
        unsigned nloc = b.st[0], nx = b.st[1];
        if (nloc == 0u) { xcd_barrier_complete(bar, b.x, nloc, nx); b.st[0] = nloc; b.st[1] = nx; }
        const unsigned old = xb_add(&bar[XB_XSUB(b.x)], 1u);
        const unsigned gen = old / nloc;
        if (old + 1u == (gen + 1u) * nloc) {
            __builtin_amdgcn_fence(__ATOMIC_RELEASE, "agent");
            asm volatile("s_waitcnt vmcnt(0)" ::: "memory");
            const unsigned og = xb_add(&bar[XB_TOP], 1u);
            const unsigned tg = og / nx;
            if (og + 1u == (tg + 1u) * nx) xb_add(&bar[XB_TOPGEN], 1u);
            else XB_SPIN(xb_ld(&bar[XB_TOPGEN]) == tg, bar);
            __builtin_amdgcn_fence(__ATOMIC_ACQUIRE, "agent");
            xb_add(&bar[XB_XGEN(b.x)], 1u);
            asm volatile("s_waitcnt vmcnt(0)" ::: "memory");
        } else {
            XB_SPIN(xb_ld(&bar[XB_XGEN(b.x)]) == gen, bar);
            __builtin_amdgcn_fence(__ATOMIC_ACQUIRE, "agent");
            asm volatile("s_waitcnt vmcnt(0)" ::: "memory");
        }
    }
    __syncthreads();
}

struct StrideOrder {
    int G, b;
    __device__ __forceinline__ bool next(int i, attn_body::AttnUnit& u) const { const int idx = b + i * G; if (idx >= 1024) return false; u.bh = idx >> 5; u.qb = 31 - (idx & 31); return true; }
    __device__ __forceinline__ void a_ready(const attn_body::AttnUnit&) const {}
    __device__ __forceinline__ void done(const attn_body::AttnUnit&) const {}
};

struct Args { const float* in[19]; float* out; unsigned char* ws; int ph_lo, ph_hi; };
__global__ void __launch_bounds__(NWAVES * 64, 2) fwd_kernel(Args args) {
    extern __shared__ __attribute__((aligned(16))) unsigned char lds[];
    __builtin_assume(__builtin_amdgcn_workitem_id_y() == 0); __builtin_assume(__builtin_amdgcn_workitem_id_z() == 0);
    LAS unsigned char* ldsp = (LAS unsigned char*)lds;
    const int tid = threadIdx.x, lane = tid & 63, wave = __builtin_amdgcn_readfirstlane(tid >> 6);
    const int G = gridDim.x, bx = blockIdx.x;
    const int vcu = (G % 8 == 0) ? (bx % 8) * (G / 8) + bx / 8 : bx;
    const int gw = vcu * NWAVES + wave, NGW = G * NWAVES;
    const int lo = args.ph_lo, hi = args.ph_hi;
    if (lo < 0) cg::this_grid().sync();
    volatile LAS unsigned* bst = (volatile LAS unsigned*)(ldsp + RING_BYTES + 32);
    if (tid == 0) { bst[0] = 0u; bst[1] = 0u; }
    __syncthreads();
    { const __attribute__((address_space(4))) Args* ap0 = (const __attribute__((address_space(4))) Args*)__builtin_amdgcn_kernarg_segment_ptr(); (void)xcd_barrier_post((unsigned*)(ap0->ws + WS_BAR), bst); }
#ifndef PHASE_MASK
#define PHASE_MASK 0xFF
#endif
#define IN(k) (((PHASE_MASK >> (k)) & 1) && lo <= (k) && (k) < hi)
#define SEAM(k) do { if (IN(k) && IN((k) + 1)) { ARGS_RELOAD(); XcdBarrier xb_; xb_.bar = WSP(unsigned, WS_BAR); xb_.x = xb_xcc_id(); xb_.st = bst; xcd_barrier(xb_); } } while (0)
#define ARGS_RELOAD() const __attribute__((address_space(4))) Args* ap = (const __attribute__((address_space(4))) Args*)__builtin_amdgcn_kernarg_segment_ptr(); asm volatile("" : "+s"(ap)); unsigned char* const ws = ap->ws
#define WSP(T, off) ((T*)(ws + (off)))

    if (IN(0)) {
        ARGS_RELOAD();
        LAS float* scr = (LAS float*)(ldsp + wave * 16384);
        constexpr int I_IN = (D / 64) * (NIN / 32);
        for (int it = vcu; it < 256; it += G) p0_fold_a_wg(ap->in[4], ap->in[5], ap->in[13], WSP(bf16, WS_WA), it, ldsp, wave, lane);
        for (int it = gw; it < I_IN; it += NGW) p0_transpose_item(ap->in[2], D, NIN, WSP(bf16, WS_WIN), D, true, nullptr, 0, 1.f, scr, it, lane);
#ifdef PROBE_RMS2
        for (int rep_ = 0; rep_ < 2; ++rep_)
#endif
        for (int m = gw; m + 3 * NGW < M; m += 4 * NGW) rms_rows_to_bf16<4>(ap->in[0], ap->in[1], WSP(bf16, WS_XN), m, NGW, lane);
        for (int m = gw + (M / (4 * NGW)) * 4 * NGW; m < M; m += NGW) rms_rows_to_bf16<1>(ap->in[0], ap->in[1], WSP(bf16, WS_XN), m, NGW, lane);
        VM_WAIT(); __syncthreads();
    }
    SEAM(0);
#ifdef PROBE_SYNC8
    for (int rep_ = 0; rep_ < 8; ++rep_) { ARGS_RELOAD(); XcdBarrier xb_; xb_.bar = WSP(unsigned, WS_BAR); xb_.x = xb_xcc_id(); xb_.st = bst; xcd_barrier(xb_); }
#endif
    if (IN(1)) {
        ARGS_RELOAD();
        pg8::Gemm g{WSP(bf16, WS_XN), WSP(bf16, WS_WIN), M, NIN, D}; pg8::StaticOrder S; S.init(M, NIN, G, bx);
        pg8::EpiIn E{WSP(bf16, WS_U), WSP(bf16, WS_Q), WSP(bf16, WS_K), WSP(bf16, WS_V), WSP(bf16, WS_G), ap->in[6], ap->in[7], ap->in[3]};
        pg8::gemm_phase<pg8::EpiIn, pg8::StaticOrder, true, true>(ldsp, g, S, E);
    }
    SEAM(1);
    if (IN(2)) {
        ARGS_RELOAD();
#ifdef PROBE_POOL2
        for (int rep_ = 0; rep_ < 2; ++rep_)
#endif
        for (int m = gw; m < M; m += NGW) pool_row(WSP(bf16, WS_U), WSP(bf16, WS_PL), m, lane);
        VM_WAIT(); __syncthreads();
        float gq = __builtin_fabsf(ap->in[6][lane]), gk = __builtin_fabsf(ap->in[7][lane]);
#pragma unroll
        for (int o = 1; o < 64; o <<= 1) { gq = __builtin_fmaxf(gq, __shfl_xor(gq, o)); gk = __builtin_fmaxf(gk, __shfl_xor(gk, o)); }
        const float smax2 = pg8::QK_C2 * 64.0f * gq * gk * 1.05f + 1.0f;
        const attn_body::bf16 *Qp = WSP(const attn_body::bf16, WS_Q), *Kp = WSP(const attn_body::bf16, WS_K), *Vp = WSP(const attn_body::bf16, WS_V); attn_body::bf16* Op = WSP(attn_body::bf16, WS_OV);
        unsigned* ctr = WSP(unsigned, WS_CTR);
        const bool nomax = __builtin_amdgcn_readfirstlane(smax2 < 60.0f ? 1 : 0) != 0;
        volatile LAS unsigned* qs = (volatile LAS unsigned*)(ldsp + RING_BYTES + 64);
        int idx2 = 0;
        for (;;) {
            if (tid == 0) *qs = atomicAdd(ctr, 1u);
            __syncthreads();
            const int idx = __builtin_amdgcn_readfirstlane((int)*qs);
            __syncthreads();
            if (idx >= 1024) { idx2 = idx; break; }
            if (nomax) {
                int b_, hc_, qb_, sp_;
                if (idx < 256) { const int r = idx & 15; qb_ = 31 - (idx >> 4); b_ = r >> 3; hc_ = 4 + ((r >> 1) & 3); sp_ = r & 1; }
                else { int j = idx - 256; sp_ = 0; if (j >= 384) { j -= 384; sp_ = 1; }
                    if (j < 128) { const int r = j & 7; qb_ = 15 - (j >> 3); b_ = r >> 2; hc_ = 4 + (r & 3); }
                    else if (j < 256) { j -= 128; const int r = j & 3; qb_ = 31 - (j >> 2); b_ = r >> 1; hc_ = 2 + (r & 1); }
                    else { j -= 256; const int r = j & 3; qb_ = 31 - (j >> 2); b_ = r >> 1; hc_ = r & 1; } }
                attn_body::attn_wide2(b_, hc_, qb_, sp_, Qp, Kp, Vp, Op, WSP(attn_body::bf16, WS_P1), WSP(float, WS_L0), WSP(float, WS_L1), (char*)lds, smax2); }
            else attn_body::attn_unit<8>((idx >> 4) & 1, idx & 15, 31 - (idx >> 5), Qp, Kp, Vp, Op, (char*)lds, smax2, false);
        }
        {   ARGS_RELOAD();
            unsigned* ctr2 = WSP(unsigned, WS_CTR);
            int tid2 = threadIdx.x; asm volatile("" : "+v"(tid2));
            const int lane2 = tid2 & 63, wave2 = __builtin_amdgcn_readfirstlane(tid2 >> 6);
            volatile LAS unsigned* qs2 = (volatile LAS unsigned*)(ldsp + RING_BYTES + 64);
            LAS float* scr2 = (LAS float*)(ldsp + wave2 * 16384);
            constexpr int I_OUT = (D / 64) * (D / 32), I_1 = (D / 64) * (FF / 32), I_2 = (FF / 64) * (D / 32), I_B = (512 / 64) * (D / 32), N_TR = (I_OUT + I_1 + I_2 + I_B) / 32;
            static_assert((I_OUT + I_1 + I_2 + I_B) % 32 == 0, "deferred transposes per workgroup item");
            while (idx2 < 1024 + N_TR) {
                for (int k = 0; k < 4; ++k) { int r = (idx2 - 1024) * 32 + wave2 * 4 + k;
                    const float* W; int K_, lg; bf16* WT; int ldw; bool hrs; const float* rs; int rsmask; float rsmul;
                    if (r < I_OUT) { W = ap->in[15]; K_ = D; lg = 5; WT = WSP(bf16, WS_WOUT); ldw = D; hrs = false; rs = W; rsmask = 0; rsmul = 1.f; }
                    else if (r < I_OUT + I_1) { r -= I_OUT; W = ap->in[17]; K_ = D; lg = 7; WT = WSP(bf16, WS_W1); ldw = D; hrs = true; rs = ap->in[16]; rsmask = 1023; rsmul = 1.f; }
                    else if (r < I_OUT + I_1 + I_2) { r -= I_OUT + I_1; W = ap->in[18]; K_ = FF; lg = 5; WT = WSP(bf16, WS_W2); ldw = FF; hrs = false; rs = W; rsmask = 0; rsmul = 1.f; }
                    else { r -= I_OUT + I_1 + I_2; W = ap->in[14]; K_ = 512; lg = 5; WT = WSP(bf16, WS_WA) + 512; ldw = 1024; hrs = true; rs = ap->in[12]; rsmask = 127; rsmul = ONE_MINUS_LINIT; }
                    p0_transpose_item_rt(W, K_, lg, WT, ldw, hrs, rs, rsmask, rsmul, scr2, r, lane2); }
                if (tid2 == 0) *qs2 = atomicAdd(ctr2, 1u);
                __syncthreads();
                idx2 = __builtin_amdgcn_readfirstlane((int)*qs2);
                __syncthreads();
            }
        }
    }
    SEAM(2);
    if (IN(3)) {
        ARGS_RELOAD();
        const float lam = expf(wave_sum(ap->in[8][lane] * ap->in[9][lane])) - expf(wave_sum(ap->in[10][lane] * ap->in[11][lane])) + LAMBDA_INIT;
        float gq = __builtin_fabsf(ap->in[6][lane]), gk = __builtin_fabsf(ap->in[7][lane]);
#pragma unroll
        for (int o = 1; o < 64; o <<= 1) { gq = __builtin_fmaxf(gq, __shfl_xor(gq, o)); gk = __builtin_fmaxf(gk, __shfl_xor(gk, o)); }
        const float smax2c = pg8::QK_C2 * 64.0f * gq * gk * 1.05f + 1.0f;
        const bool nomax = __builtin_amdgcn_readfirstlane(smax2c < 60.0f ? 1 : 0) != 0;
        if (nomax) { int m = gw; for (; m + 3 * NGW < M; m += 4 * NGW) combine_wide<4>(WSP(bf16, WS_OV), WSP(bf16, WS_P1), WSP(float, WS_L0), WSP(float, WS_L1), WSP(bf16, WS_PL), m, NGW, lam, smax2c, lane);
                     for (; m < M; m += NGW) combine_wide<1>(WSP(bf16, WS_OV), WSP(bf16, WS_P1), WSP(float, WS_L0), WSP(float, WS_L1), WSP(bf16, WS_PL), m, NGW, lam, smax2c, lane); }
        else for (int m = gw; m < M; m += NGW) combine_row(WSP(bf16, WS_OV), WSP(bf16, WS_PL), m, lam, lane);
        VM_WAIT(); __syncthreads();
    }
    SEAM(3);
    if (IN(4)) {
        ARGS_RELOAD();
        pg8::Gemm g{WSP(bf16, WS_PL), WSP(bf16, WS_WA), M, D, 1024}; pg8::StaticOrder S; S.init(M, D, G, bx);
        pg8::EpiMerge E{WSP(bf16, WS_G), WSP(bf16, WS_MG)};
        pg8::gemm_phase<pg8::EpiMerge, pg8::StaticOrder, true, true>(ldsp, g, S, E);
    }
    SEAM(4);
    if (IN(5)) {
        ARGS_RELOAD();
        pg8::Gemm g{WSP(bf16, WS_MG), WSP(bf16, WS_WOUT), M, D, D}; pg8::StaticOrder S; S.init(M, D, G, bx);
        pg8::EpiOut E{ap->in[0], WSP(bf16, WS_X1B), WSP(float, WS_SSQ)};
        pg8::gemm_phase<pg8::EpiOut, pg8::StaticOrder, true, true>(ldsp, g, S, E);
    }
    SEAM(5);
    if (IN(6)) {
        ARGS_RELOAD();
        pg8::Gemm g{WSP(bf16, WS_X1B), WSP(bf16, WS_W1), M, FF, D}; pg8::StaticOrder S; S.init(M, FF, G, bx);
        pg8::Unit u0{-1, 0}; (void)S.next(0, u0);
        LAS float* rtab = (LAS float*)(ldsp + RING_BYTES + 1024);
        if (u0.pm >= 0 && tid < 256) { const f32x4* sp = (const f32x4*)(WSP(float, WS_SSQ) + (size_t)(u0.pm * 256 + tid) * 16); const f32x4 s4 = (sp[0] + sp[1]) + (sp[2] + sp[3]);
            rtab[tid] = __builtin_amdgcn_rsqf(((s4[0] + s4[1]) + (s4[2] + s4[3])) * (1.0f / 1024.0f) + 1e-6f); }
        LDS_WAIT(); __syncthreads();
        pg8::EpiFF1 E{WSP(float, WS_SSQ), WSP(bf16, WS_H), u0.pm, rtab};
        pg8::gemm_phase<pg8::EpiFF1, pg8::StaticOrder, true, true>(ldsp, g, S, E);
    }
    SEAM(6);
    if (IN(7)) {
        ARGS_RELOAD();
        pg8::Gemm g{WSP(bf16, WS_H), WSP(bf16, WS_W2), M, D, FF}; pg8::StaticOrder S; S.init(M, D, G, bx);
        pg8::EpiFF2 E{WSP(bf16, WS_X1B), ap->out};
        pg8::gemm_phase<pg8::EpiFF2, pg8::StaticOrder, true, true>(ldsp, g, S, E);
    }
#undef IN
#undef SEAM
#undef ARGS_RELOAD
#undef WSP
}

#ifdef DBG_STOP
__global__ void dbg_dump(const unsigned short* __restrict__ buf, float* __restrict__ out, size_t n) {
    for (size_t i = (size_t)blockIdx.x * blockDim.x + threadIdx.x; i < n; i += (size_t)gridDim.x * blockDim.x) out[i] = __uint_as_float((unsigned)buf[i] << 16);
}
__global__ void dbg_dump32(const float* __restrict__ buf, float* __restrict__ out, size_t n) {
    for (size_t i = (size_t)blockIdx.x * blockDim.x + threadIdx.x; i < n; i += (size_t)gridDim.x * blockDim.x) out[i] = buf[i];
}
#endif
extern "C" void kernel_launch(void* const* d_in, const int* in_sizes, int n_in, void* d_out, int out_size, void* d_ws, size_t ws_size, hipStream_t stream) {
    static int grid = 0;
    if (grid == 0) {
        if (n_in != 19 || out_size != M * D || ws_size < WS_END) { fprintf(stderr, "kernel_launch: unexpected shapes (n_in %d out %d ws %zu)\n", n_in, out_size, ws_size); grid = -1; return; }
        int dev = 0, cus = 0, per_cu = 0;
        hipGetDevice(&dev); hipDeviceGetAttribute(&cus, hipDeviceAttributeMultiprocessorCount, dev);
        if (hipFuncSetAttribute((const void*)fwd_kernel, hipFuncAttributeMaxDynamicSharedMemorySize, LDS_BYTES) != hipSuccess) { fprintf(stderr, "kernel_launch: hipFuncSetAttribute failed\n"); grid = -1; return; }
        if (hipOccupancyMaxActiveBlocksPerMultiprocessor(&per_cu, (const void*)fwd_kernel, NWAVES * 64, LDS_BYTES) != hipSuccess || per_cu < 1) per_cu = 1;
        (void)hipGetLastError();
        grid = cus * per_cu;
    }
    if (grid < 0) return;
    Args a{};
    for (int i = 0; i < 19; ++i) a.in[i] = (const float*)d_in[i];
    a.out = (float*)d_out; a.ws = (unsigned char*)d_ws;
#if MK_N_LAUNCHES == 1
    void* kargs[] = {&a};
    (void)hipMemsetAsync(d_ws, 0, WS_CTL_BYTES, stream);
#ifdef PROBE_DUP
    a.ph_lo = 0; a.ph_hi = PROBE_DUP_HI;
    (void)hipLaunchCooperativeKernel((const void*)fwd_kernel, dim3(grid), dim3(NWAVES * 64), kargs, LDS_BYTES, stream);
    (void)hipMemsetAsync(d_ws, 0, WS_CTL_BYTES, stream);
    a.ph_lo = PROBE_DUP_LO; a.ph_hi = N_PHASES;
#else
    a.ph_lo = 0; a.ph_hi = N_PHASES;
#endif
    hipError_t e = hipLaunchCooperativeKernel((const void*)fwd_kernel, dim3(grid), dim3(NWAVES * 64), kargs, LDS_BYTES, stream);
    if (e != hipSuccess) fprintf(stderr, "kernel_launch: cooperative launch failed: %s (grid %d)\n", hipGetErrorString(e), grid);
#else
#ifdef DBG_STOP
    for (int p = 0; p <= DBG_STOP; ++p) { a.ph_lo = p; a.ph_hi = p + 1; hipLaunchKernelGGL(fwd_kernel, dim3(grid), dim3(NWAVES * 64), LDS_BYTES, stream, a); }
#ifdef DBG_F32
    hipLaunchKernelGGL(dbg_dump32, dim3(2048), dim3(256), 0, stream, (const float*)((unsigned char*)d_ws + DBG_OFF), (float*)d_out, (size_t)M * D);
#else
    hipLaunchKernelGGL(dbg_dump, dim3(2048), dim3(256), 0, stream, (const unsigned short*)((unsigned char*)d_ws + DBG_OFF), (float*)d_out, (size_t)M * D);
#endif
#else
    for (int p = 0; p < N_PHASES; ++p) { a.ph_lo = p; a.ph_hi = p + 1; hipLaunchKernelGGL(fwd_kernel, dim3(grid), dim3(NWAVES * 64), LDS_BYTES, stream, a); }
#endif
#endif
}
```

```cpp
#include <hip/hip_runtime.h>
#include <hip/hip_cooperative_groups.h>
#include <cstdio>
#include <cstdint>
#include <hip/hip_bf16.h>
#include <cmath>
namespace pg8 {
#define PG8_LAS __attribute__((address_space(3)))
typedef unsigned short bf16_t;
typedef short bf16x8 __attribute__((ext_vector_type(8)));
typedef float f32x4 __attribute__((ext_vector_type(4)));
typedef unsigned u32x4 __attribute__((ext_vector_type(4)));
constexpr int BM = 256, BK = 64, HALF = 128, HTB = HALF * BK * 2  , STAGE_BYTES = 8 * HTB, NXCD = 8, WGM = 8;

__host__ __device__ __forceinline__ int lds_byte(int r, int c) { const int st = (r >> 4) * 2 + (c >> 5), rr = r & 15, cc = c & 31, ob = rr * 64 + cc * 2; return st * 1024 + (ob ^ (((ob >> 9) & 1) << 5)); }
__host__ __device__ __forceinline__ void stage_rc(int b, int& R, int& C) { const int st = b / 1024, sb = b % 1024, swz = sb ^ (((sb >> 9) & 1) << 5); R = (st >> 1) * 16 + swz / 64; C = (st & 1) * 32 + (swz % 64) / 2; }
__host__ __device__ __forceinline__ int perm32(int rho) { const int n = rho >> 4, i = rho & 15; return 8 * (i >> 2) + 4 * n + (i & 3); }

struct Unit { int pm, pn; };
struct Gemm { const bf16_t* A; const bf16_t* Bt; int M, N, K; };

struct StaticOrder {
    int nM, nN, nwg, G, c;
    __host__ __device__ void init(int M, int N, int G_, int c_) { nM = M / BM; nN = N / BM; nwg = nM * nN; G = G_; c = c_; }
    __host__ __device__ bool next(int i, Unit& u) const {
        const long L = (long)i * G + c; if (L >= nwg) return false;
        int wgid = (int)L; { const int q = nwg / NXCD, r = nwg % NXCD, xcd = wgid % NXCD, off = wgid / NXCD; wgid = (xcd < r ? xcd * (q + 1) : r * (q + 1) + (xcd - r) * q) + off; }
        const int nig = WGM * nN, gid = wgid / nig, fm = gid * WGM, gsz = (nM - fm) < WGM ? (nM - fm) : WGM;
        u.pm = fm + ((wgid % nig) % gsz); u.pn = (wgid % nig) / gsz; return true;
    }
    __device__ __forceinline__ void a_ready(const Unit&) const {}
    __device__ __forceinline__ void done(const Unit&) const {}
};

typedef float cvt_f32x2_t __attribute__((ext_vector_type(2))); typedef __bf16 cvt_bf16x2_t __attribute__((ext_vector_type(2)));
__device__ __forceinline__ unsigned cvt_pk_bf16(float lo, float hi) { cvt_f32x2_t v = {lo, hi}; cvt_bf16x2_t b = __builtin_convertvector(v, cvt_bf16x2_t); return __builtin_bit_cast(unsigned, b); }
typedef float f32x2 __attribute__((ext_vector_type(2)));
__device__ __forceinline__ u32x4 pack8(const f32x4 a, const f32x4 b) { u32x4 w; w.x = cvt_pk_bf16(a[0], a[1]); w.y = cvt_pk_bf16(a[2], a[3]); w.z = cvt_pk_bf16(b[0], b[1]); w.w = cvt_pk_bf16(b[2], b[3]); return w; }
__device__ __forceinline__ void unpack8(const u32x4 w, f32x4& a, f32x4& b) {
    a[0] = __uint_as_float(w.x << 16); a[1] = __uint_as_float(w.x & 0xffff0000u); a[2] = __uint_as_float(w.y << 16); a[3] = __uint_as_float(w.y & 0xffff0000u);
    b[0] = __uint_as_float(w.z << 16); b[1] = __uint_as_float(w.z & 0xffff0000u); b[2] = __uint_as_float(w.w << 16); b[3] = __uint_as_float(w.w & 0xffff0000u); }
__device__ __forceinline__ float dot4(const f32x4 x) { return (x[0] * x[0] + x[1] * x[1]) + (x[2] * x[2] + x[3] * x[3]); }
__device__ __forceinline__ f32x4 sigmoid4(const f32x4 x) { f32x4 o;
#pragma unroll
    for (int e = 0; e < 4; ++e) o[e] = __builtin_amdgcn_rcpf(1.0f + __builtin_amdgcn_exp2f(x[e] * -1.4426950408889634f));
    return o; }
constexpr float QK_C2 = 0.125f * 1.4426950408889634f;
struct EpiIn {
    static constexpr bool PERM = true, AFTER_DRAIN = false, HOOK = false, INIT = false;
    bf16_t *U, *Q, *K, *V, *G; const float *qg, *kg, *gb;
    __device__ __forceinline__ void operator()(const f32x4 (&acc)[2][2][4][2], const Unit& u, int wr, int wc, int fr, int fq) const {
        const int pn = u.pn, row0 = u.pm * BM + wr * 64 + fr, cw = 64 * wc + 8 * fq;
        if (pn < 2 || pn == 6 || pn == 7) {
            bf16_t* base = (pn < 2) ? (U + pn * 256) : (V + (pn - 6) * 256);
#pragma unroll
            for (int ai = 0; ai < 2; ++ai)
#pragma unroll
                for (int m = 0; m < 4; ++m) { bf16_t* rowp = base + (size_t)(row0 + ai * HALF + m * 16) * 512 + cw;
#pragma unroll
                    for (int bj = 0; bj < 2; ++bj) *(u32x4*)(rowp + 32 * bj) = pack8(acc[ai][bj][m][0], acc[ai][bj][m][1]); }
        } else if (pn < 6) {
            const bool isq = pn < 4;
            bf16_t* base = isq ? (Q + (pn - 2) * 256) : (K + (pn - 4) * 256);
            const float* g = isq ? qg : kg; const float mul = isq ? QK_C2 : 1.0f;
            f32x4 gv[2][2];
#pragma unroll
            for (int bj = 0; bj < 2; ++bj)
#pragma unroll
                for (int n = 0; n < 2; ++n) gv[bj][n] = *(const f32x4*)(g + 32 * bj + 8 * fq + 4 * n) * mul;
#pragma unroll
            for (int ai = 0; ai < 2; ++ai)
#pragma unroll
                for (int m = 0; m < 4; ++m) { float ss = 0.f;
#pragma unroll
                    for (int bj = 0; bj < 2; ++bj)
#pragma unroll
                        for (int n = 0; n < 2; ++n) ss += dot4(acc[ai][bj][m][n]);
                    ss += __shfl_xor(ss, 16); ss += __shfl_xor(ss, 32);
                    const float r = __builtin_amdgcn_rsqf(ss * (1.0f / 64.0f) + 1e-6f);
                    bf16_t* rowp = base + (size_t)(row0 + ai * HALF + m * 16) * 512 + cw;
#pragma unroll
                    for (int bj = 0; bj < 2; ++bj) *(u32x4*)(rowp + 32 * bj) = pack8(acc[ai][bj][m][0] * r * gv[bj][0], acc[ai][bj][m][1] * r * gv[bj][1]); }
        } else {
            const int gc = (pn - 8) * 256 + cw;
            f32x4 bv[2][2];
#pragma unroll
            for (int bj = 0; bj < 2; ++bj)
#pragma unroll
                for (int n = 0; n < 2; ++n) bv[bj][n] = *(const f32x4*)(gb + gc + 32 * bj + 4 * n);
#pragma unroll
            for (int ai = 0; ai < 2; ++ai)
#pragma unroll
                for (int m = 0; m < 4; ++m) { bf16_t* rowp = G + (size_t)(row0 + ai * HALF + m * 16) * 2048 + gc;
#pragma unroll
                    for (int bj = 0; bj < 2; ++bj) *(u32x4*)(rowp + 32 * bj) = pack8(sigmoid4(acc[ai][bj][m][0] + bv[bj][0]), sigmoid4(acc[ai][bj][m][1] + bv[bj][1])); }
        }
    }
};
struct EpiMerge {
    static constexpr bool PERM = true, AFTER_DRAIN = false, HOOK = true, INIT = false; static constexpr int HOOK_T = 8;
    const bf16_t* G; bf16_t* MG;
    __device__ __forceinline__ void hook(f32x4 (&acc)[2][2][4][2], const Unit& u, int wr, int wc, int fr, int fq) const {
        asm volatile("" : "+v"(fr), "+v"(fq));
        const int row0 = u.pm * BM + wr * 64 + fr, col0 = u.pn * BM + wc * 32 + 8 * fq;
#pragma unroll
        for (int ai = 0; ai < 2; ++ai)
#pragma unroll
            for (int m = 0; m < 4; ++m) { const size_t row = (size_t)(row0 + ai * HALF + m * 16);
#pragma unroll
                for (int bj = 0; bj < 2; ++bj) { const int c = col0 + bj * HALF; f32x4 a0, a1, b0, b1; unpack8(*(const u32x4*)(G + row * 2048 + c), a0, a1); unpack8(*(const u32x4*)(G + row * 2048 + 1024 + c), b0, b1);
#pragma unroll
                    for (int e = 0; e < 4; ++e) { a0[e] *= __builtin_amdgcn_rcpf(__builtin_fmaxf(b0[e], 1e-30f)); a1[e] *= __builtin_amdgcn_rcpf(__builtin_fmaxf(b1[e], 1e-30f)); }
                    acc[ai][bj][m][0] *= a0; acc[ai][bj][m][1] *= a1; }
                if (m == 3) asm volatile("" ::: "memory"); }
    }
    __device__ __forceinline__ void operator()(const f32x4 (&acc)[2][2][4][2], const Unit& u, int wr, int wc, int fr, int fq) const {
        const int row0 = u.pm * BM + wr * 64 + fr, col0 = u.pn * BM + wc * 32 + 8 * fq;
#pragma unroll
        for (int ai = 0; ai < 2; ++ai)
#pragma unroll
            for (int m = 0; m < 4; ++m) { const size_t row = (size_t)(row0 + ai * HALF + m * 16);
#pragma unroll
                for (int bj = 0; bj < 2; ++bj) { const int c = col0 + bj * HALF; f32x4 b0, b1; unpack8(*(const u32x4*)(G + row * 2048 + 1024 + c), b0, b1);
                    *(u32x4*)(MG + row * 1024 + c) = pack8(acc[ai][bj][m][0] * b0, acc[ai][bj][m][1] * b1); } }
    }
};
struct EpiOut {
    static constexpr bool PERM = true, AFTER_DRAIN = false, HOOK = false, INIT = true;
    const float* X; bf16_t* X1B; float* SSQ;
    __device__ __forceinline__ void init(f32x4 (&acc)[2][2][4][2], const Unit& u, int wr, int wc, int fr, int fq) const {
        const int row0 = u.pm * BM + wr * 64 + fr, col0 = u.pn * BM + wc * 32 + 8 * fq;
#pragma unroll
        for (int ai = 0; ai < 2; ++ai)
#pragma unroll
            for (int m = 0; m < 4; ++m) { const size_t row = (size_t)(row0 + ai * HALF + m * 16);
#pragma unroll
                for (int bj = 0; bj < 2; ++bj) { const int c = col0 + bj * HALF; acc[ai][bj][m][0] = *(const f32x4*)(X + row * 1024 + c); acc[ai][bj][m][1] = *(const f32x4*)(X + row * 1024 + c + 4); } }
    }
    __device__ __forceinline__ void operator()(const f32x4 (&acc)[2][2][4][2], const Unit& u, int wr, int wc, int fr, int fq) const {
        const int row0 = u.pm * BM + wr * 64 + fr, col0 = u.pn * BM + wc * 32 + 8 * fq;
#pragma unroll
        for (int ai = 0; ai < 2; ++ai)
#pragma unroll
            for (int m = 0; m < 4; ++m) { const size_t row = (size_t)(row0 + ai * HALF + m * 16); float ss = 0.f;
#pragma unroll
                for (int bj = 0; bj < 2; ++bj) { const int c = col0 + bj * HALF;
                    const f32x4 v0 = acc[ai][bj][m][0], v1 = acc[ai][bj][m][1];
                    *(u32x4*)(X1B + row * 1024 + c) = pack8(v0, v1);
                    ss += dot4(v0) + dot4(v1); }
                ss += __shfl_xor(ss, 16); ss += __shfl_xor(ss, 32);
                if (fq == 0) SSQ[row * 16 + u.pn * 4 + wc] = ss; }
    }
};
struct EpiFF1 {
    static constexpr bool PERM = true, AFTER_DRAIN = false, HOOK = false, INIT = false;
    const float* SSQ; bf16_t* H; int pm_tab; const PG8_LAS float* rtab;
    __device__ __forceinline__ void operator()(const f32x4 (&acc)[2][2][4][2], const Unit& u, int wr, int wc, int fr, int fq) const {
        const int row0 = u.pm * BM + wr * 64 + fr, col0 = u.pn * BM + wc * 32 + 8 * fq;
        const bool tab = (u.pm == pm_tab);
#pragma unroll
        for (int ai = 0; ai < 2; ++ai)
#pragma unroll
            for (int m = 0; m < 4; ++m) { const size_t row = (size_t)(row0 + ai * HALF + m * 16);
                float r;
                if (tab) r = rtab[ai * HALF + wr * 64 + m * 16 + fr];
                else { const f32x4* sp = (const f32x4*)(SSQ + row * 16); const f32x4 s4 = (sp[0] + sp[1]) + (sp[2] + sp[3]);
                    r = __builtin_amdgcn_rsqf(((s4[0] + s4[1]) + (s4[2] + s4[3])) * (1.0f / 1024.0f) + 1e-6f); }
#pragma unroll
                for (int bj = 0; bj < 2; ++bj) { const int c = col0 + bj * HALF; f32x4 v0 = acc[ai][bj][m][0] * r, v1 = acc[ai][bj][m][1] * r;
#pragma unroll
                    for (int e = 0; e < 4; ++e) { v0[e] = __builtin_fmaxf(v0[e], 0.f); v1[e] = __builtin_fmaxf(v1[e], 0.f); }
                    *(u32x4*)(H + row * 4096 + c) = pack8(v0 * v0, v1 * v1); } }
    }
};
struct EpiFF2 {
    static constexpr bool PERM = true, AFTER_DRAIN = false, HOOK = false, INIT = true;
    const bf16_t* X1B; float* OUT;
    __device__ __forceinline__ void init(f32x4 (&acc)[2][2][4][2], const Unit& u, int wr, int wc, int fr, int fq) const {
        const int row0 = u.pm * BM + wr * 64 + fr, col0 = u.pn * BM + wc * 32 + 8 * fq;
#pragma unroll
        for (int ai = 0; ai < 2; ++ai)
#pragma unroll
            for (int m = 0; m < 4; ++m) { const size_t row = (size_t)(row0 + ai * HALF + m * 16);
#pragma unroll
                for (int bj = 0; bj < 2; ++bj) { const int c = col0 + bj * HALF; unpack8(*(const u32x4*)(X1B + row * 1024 + c), acc[ai][bj][m][0], acc[ai][bj][m][1]); } }
    }
    __device__ __forceinline__ void operator()(const f32x4 (&acc)[2][2][4][2], const Unit& u, int wr, int wc, int fr, int fq) const {
        const int row0 = u.pm * BM + wr * 64 + fr, col0 = u.pn * BM + wc * 32 + 8 * fq;
#pragma unroll
        for (int ai = 0; ai < 2; ++ai)
#pragma unroll
            for (int m = 0; m < 4; ++m) { const size_t row = (size_t)(row0 + ai * HALF + m * 16);
#pragma unroll
                for (int bj = 0; bj < 2; ++bj) { float* p = OUT + row * 1024 + col0 + bj * HALF; *(f32x4*)p = acc[ai][bj][m][0]; *(f32x4*)(p + 4) = acc[ai][bj][m][1]; } }
    }
};

template <class Epi, class Sched, bool ALIGN_EPI = false, bool SP2 = false>
__device__ __forceinline__ void gemm_phase(PG8_LAS unsigned char* lds, const Gemm g, const Sched& S, const Epi& E) {
    const int tid = threadIdx.x, wid = __builtin_amdgcn_readfirstlane(tid >> 6), lane = tid & 63, wr = wid >> 2, wc = wid & 3, fr = lane & 15, fq = lane >> 4;
    const int K = g.K, nt = K / BK;
    unsigned voffA[2], voffB[2];
#pragma unroll
    for (int i = 0; i < 2; ++i) { int R, C; stage_rc(tid * 16 + i * 8192, R, C); const int Rb = Epi::PERM ? ((R & ~31) + perm32(R & 31)) : R;
        voffA[i] = (unsigned)(R * K + C) * 2u; voffB[i] = (unsigned)(Rb * K + C) * 2u; }
    const size_t kstep = (size_t)(BK * 2);
    const size_t hstep = (size_t)HALF * K * 2;
    const size_t tstep = 2 * hstep;
    const unsigned ldsw = (unsigned)wid * 1024u;
    const int aoff = lds_byte(wr * 64 + fr, fq * 8), boff = lds_byte(wc * 32 + fr, fq * 8);
#define PG8_SA(b, h) (((b) * 2 + (h)) * HTB)
#define PG8_SB(b, h) ((4 + (b) * 2 + (h)) * HTB)
#define PG8_STAGE(bufoff, gbase, voff) do { _Pragma("unroll") for (int _i = 0; _i < 2; ++_i) \
        __builtin_amdgcn_global_load_lds((const unsigned*)((const char*)(gbase) + (voff)[_i]), (PG8_LAS unsigned*)(lds + (bufoff) + ldsw + _i * 8192), 16, 0, 0); } while (0)
#define PG8_LDA(dst, b, h) do { _Pragma("unroll") for (int m = 0; m < 4; ++m) _Pragma("unroll") for (int k = 0; k < 2; ++k) dst[m][k] = *(const PG8_LAS bf16x8*)(lds + PG8_SA(b, h) + aoff + m * 2048 + k * 1024); } while (0)
#define PG8_LDB(dst, b, h) do { _Pragma("unroll") for (int n = 0; n < 2; ++n) _Pragma("unroll") for (int k = 0; k < 2; ++k) dst[n][k] = *(const PG8_LAS bf16x8*)(lds + PG8_SB(b, h) + boff + n * 2048 + k * 1024); } while (0)
#define PG8_MMA(ai, bj, At, Bt) do { __builtin_amdgcn_s_setprio(1); _Pragma("unroll") for (int m = 0; m < 4; ++m) _Pragma("unroll") for (int n = 0; n < 2; ++n) _Pragma("unroll") for (int k = 0; k < 2; ++k) \
        acc[ai][bj][m][n] = __builtin_amdgcn_mfma_f32_16x16x32_bf16(Bt[n][k], At[m][k], acc[ai][bj][m][n], 0, 0, 0); __builtin_amdgcn_s_setprio(0); } while (0)
#define PG8_WAIT_V(n) asm volatile("s_waitcnt vmcnt(" #n ")" ::: "memory")
#define PG8_WAIT_L(n) asm volatile("s_waitcnt lgkmcnt(" #n ")" ::: "memory")
#define PG8_BAR __builtin_amdgcn_s_barrier()
#define PG8_SCHED __builtin_amdgcn_sched_barrier(0)
    Unit cur, nxt; int ui = 0;
    if (!S.next(0, cur)) return;
    f32x4 acc[2][2][4][2];
    if constexpr (!Epi::INIT) {
#pragma unroll
    for (int a = 0; a < 2; ++a)
#pragma unroll
        for (int b = 0; b < 2; ++b)
#pragma unroll
            for (int m = 0; m < 4; ++m)
#pragma unroll
                for (int n = 0; n < 2; ++n) acc[a][b][m][n] = (f32x4){0.f, 0.f, 0.f, 0.f};
    }
    bf16x8 At[4][2], B0[2][2], B1[2][2];
    const char* cA = (const char*)g.A + (size_t)cur.pm * tstep; const char* cB = (const char*)g.Bt + (size_t)cur.pn * tstep;
    S.a_ready(cur);
    if constexpr (SP2) {
        PG8_STAGE(PG8_SB(0, 0), cB, voffB); PG8_STAGE(PG8_SB(0, 1), cB + hstep, voffB); PG8_STAGE(PG8_SA(0, 0), cA, voffA); PG8_STAGE(PG8_SA(0, 1), cA + hstep, voffA);
        if constexpr (Epi::INIT) E.init(acc, cur, wr, wc, fr, fq);
        if (wr == 1) PG8_BAR;
        PG8_WAIT_V(2); PG8_BAR;
        PG8_STAGE(PG8_SB(1, 0), cB + kstep, voffB); PG8_STAGE(PG8_SA(1, 0), cA + kstep, voffA); PG8_STAGE(PG8_SB(1, 1), cB + hstep + kstep, voffB);
        PG8_WAIT_V(6); PG8_BAR;
    } else {
        PG8_STAGE(PG8_SB(0, 0), cB, voffB); PG8_STAGE(PG8_SA(0, 0), cA, voffA); PG8_STAGE(PG8_SB(0, 1), cB + hstep, voffB); PG8_STAGE(PG8_SA(0, 1), cA + hstep, voffA);
        if constexpr (Epi::INIT) E.init(acc, cur, wr, wc, fr, fq);
        if (wr == 1) PG8_BAR;
        PG8_WAIT_V(4); PG8_BAR;
        PG8_STAGE(PG8_SB(1, 0), cB + kstep, voffB); PG8_STAGE(PG8_SA(1, 0), cA + kstep, voffA); PG8_STAGE(PG8_SB(1, 1), cB + hstep + kstep, voffB);
        PG8_WAIT_V(6); PG8_BAR;
    }
    for (;;) {
        const bool has_next = S.next(ui + 1, nxt);
        const char* nA = has_next ? (const char*)g.A + (size_t)nxt.pm * tstep : cA; const char* nB = has_next ? (const char*)g.Bt + (size_t)nxt.pn * tstep : cB;
        for (int t = 0; t < nt; t += 2) {
            const bool last = (t == nt - 2);
            if constexpr (Epi::HOOK) { if (t == Epi::HOOK_T) E.hook(acc, cur, wr, wc, fr, fq); }
            const char* a1 = cA + (size_t)(t + 1) * kstep;
            const char* a2 = last ? nA : cA + (size_t)(t + 2) * kstep; const char* b2 = last ? nB : cB + (size_t)(t + 2) * kstep;
            const char* a3 = a2 + kstep; const char* b3 = b2 + kstep;
            if (last && has_next) S.a_ready(nxt);
            if constexpr (SP2) {
            PG8_LDB(B0, 0, 0); PG8_LDB(B1, 0, 1); PG8_SCHED; PG8_LDA(At, 0, 0); PG8_STAGE(PG8_SA(1, 1), a1 + hstep, voffA);
            PG8_WAIT_V(8); PG8_WAIT_L(0); PG8_BAR; PG8_MMA(0, 0, At, B0); PG8_MMA(0, 1, At, B1); PG8_BAR; PG8_SCHED;
            PG8_LDA(At, 0, 1); PG8_STAGE(PG8_SB(0, 0), b2, voffB); PG8_STAGE(PG8_SB(0, 1), b2 + hstep, voffB); PG8_STAGE(PG8_SA(0, 0), a2, voffA);
            PG8_WAIT_V(8); PG8_WAIT_L(0); PG8_BAR; PG8_MMA(1, 0, At, B0); PG8_MMA(1, 1, At, B1); PG8_BAR; PG8_SCHED;
            PG8_LDB(B0, 1, 0); PG8_LDB(B1, 1, 1); PG8_SCHED; PG8_LDA(At, 1, 0); PG8_STAGE(PG8_SA(0, 1), a2 + hstep, voffA);
            PG8_WAIT_V(8); PG8_WAIT_L(0); PG8_BAR; PG8_MMA(0, 0, At, B0); PG8_MMA(0, 1, At, B1); PG8_BAR; PG8_SCHED;
            PG8_LDA(At, 1, 1); PG8_STAGE(PG8_SB(1, 0), b3, voffB); PG8_STAGE(PG8_SB(1, 1), b3 + hstep, voffB); PG8_STAGE(PG8_SA(1, 0), a3, voffA);
            PG8_WAIT_V(8); PG8_WAIT_L(0); PG8_BAR; PG8_MMA(1, 0, At, B0); PG8_MMA(1, 1, At, B1); PG8_BAR; PG8_SCHED;
            } else {
            PG8_LDB(B0, 0, 0); PG8_SCHED; PG8_LDA(At, 0, 0); PG8_STAGE(PG8_SA(1, 1), a1 + hstep, voffA);
            PG8_WAIT_L(8); PG8_BAR; PG8_WAIT_L(0); PG8_MMA(0, 0, At, B0); PG8_BAR; PG8_SCHED;
            PG8_LDB(B1, 0, 1); PG8_STAGE(PG8_SB(0, 0), b2, voffB);
            PG8_BAR; PG8_WAIT_L(0); PG8_MMA(0, 1, At, B1); PG8_BAR;
            PG8_LDA(At, 0, 1); PG8_STAGE(PG8_SA(0, 0), a2, voffA);
            PG8_BAR; PG8_WAIT_L(0); PG8_MMA(1, 0, At, B0); PG8_BAR; PG8_SCHED;
            PG8_STAGE(PG8_SB(0, 1), b2 + hstep, voffB);
            PG8_WAIT_V(6); PG8_BAR; PG8_MMA(1, 1, At, B1); PG8_BAR;
            PG8_LDB(B0, 1, 0); PG8_SCHED; PG8_LDA(At, 1, 0); PG8_STAGE(PG8_SA(0, 1), a2 + hstep, voffA);
            PG8_WAIT_L(8); PG8_BAR; PG8_WAIT_L(0); PG8_MMA(0, 0, At, B0); PG8_BAR; PG8_SCHED;
            PG8_LDB(B1, 1, 1); PG8_STAGE(PG8_SB(1, 0), b3, voffB);
            PG8_BAR; PG8_WAIT_L(0); PG8_MMA(0, 1, At, B1); PG8_BAR;
            PG8_LDA(At, 1, 1); PG8_STAGE(PG8_SA(1, 0), a3, voffA);
            PG8_BAR; PG8_WAIT_L(0); PG8_MMA(1, 0, At, B0); PG8_BAR; PG8_SCHED;
            PG8_STAGE(PG8_SB(1, 1), b3 + hstep, voffB);
            PG8_WAIT_V(6); PG8_BAR; PG8_MMA(1, 1, At, B1); PG8_BAR;
            }
        }
        if constexpr (ALIGN_EPI) { if (wr == 0) PG8_BAR; }
        if constexpr (!Epi::AFTER_DRAIN) { E(acc, cur, wr, wc, fr, fq); S.done(cur); }
        if (!has_next) break;
        if constexpr (Epi::INIT) E.init(acc, nxt, wr, wc, fr, fq); else
#pragma unroll
        for (int a = 0; a < 2; ++a)
#pragma unroll
            for (int b = 0; b < 2; ++b)
#pragma unroll
                for (int m = 0; m < 4; ++m)
#pragma unroll
                    for (int n = 0; n < 2; ++n) acc[a][b][m][n] = (f32x4){0.f, 0.f, 0.f, 0.f};
        cur = nxt; cA = nA; cB = nB; ++ui;
        if constexpr (ALIGN_EPI) { if (wr == 1) PG8_BAR; }
    }
    PG8_WAIT_V(0);
    if constexpr (!ALIGN_EPI) { if (wr == 0) PG8_BAR; }
    PG8_BAR;
    if constexpr (Epi::AFTER_DRAIN) { E.fused(acc, cur, wr, wc, fr, fq, lds, wid, lane); S.done(cur); }
#undef PG8_SA
#undef PG8_SB
#undef PG8_STAGE
#undef PG8_LDA
#undef PG8_LDB
#undef PG8_MMA
#undef PG8_WAIT_V
#undef PG8_WAIT_L
#undef PG8_BAR
#undef PG8_SCHED
}
}
namespace attn_body {
using bf16=__hip_bfloat16;
using bf16x8=__attribute__((ext_vector_type(8)))short;
using s16x4=__attribute__((ext_vector_type(4)))short;
using f32x16=__attribute__((ext_vector_type(16)))float;
using u32x4=__attribute__((ext_vector_type(4)))unsigned;
constexpr int BATCH=2,NHEAD=16,SEQ=8192,D=64,DM=512,PO=1024;
constexpr int NW=8,QBLK=32,QB=QBLK*NW,KVBLK=64,NQB=SEQ/QB;
constexpr int ATTN_UNIT_ROWS=QB;
__device__ __forceinline__ int crow(int r,int hi){return (r&3)+8*(r>>2)+4*hi;}
#define SBAR() __builtin_amdgcn_sched_barrier(0)
__device__ __forceinline__ void cmask(f32x16&p0,f32x16&p1,int jb,int qrel,int hi){
  const float NEG=-INFINITY; int kb=64*jb+4*hi;
  #pragma unroll
  for(int r=0;r<16;++r){int kv=kb+(r&3)+8*(r>>2); if(kv>qrel)p0[r]=NEG; if(kv+32>qrel)p1[r]=NEG;}
}

constexpr int NSLOT=3, SLOTB=8192;
constexpr int LDS_K=0, LDS_V=NSLOT*SLOTB, LDS_WS=2*NSLOT*SLOTB, LDS_OST=LDS_WS+NW*64*4, LDS_BYTES=LDS_OST+NW*4096;
constexpr float C2=0.125f*1.4426950408889634f;
__device__ __forceinline__ void glds16(const void*gsrc,unsigned lds_dst){unsigned keep;
  asm volatile("s_mov_b32 %0, m0\n\ts_mov_b32 m0, %2\n\ts_nop 0\n\tglobal_load_lds_dwordx4 %1, off\n\ts_mov_b32 m0, %0":"=&s"(keep):"v"(gsrc),"s"(lds_dst):"memory");}
__device__ __forceinline__ void glds16s(const void*sbase,unsigned voff,unsigned lds_dst){unsigned keep;
  asm volatile("s_mov_b32 %0, m0\n\ts_mov_b32 m0, %3\n\ts_nop 0\n\tglobal_load_lds_dwordx4 %1, %2\n\ts_mov_b32 m0, %0":"=&s"(keep):"v"(voff),"s"(sbase),"s"(lds_dst):"memory");}
__device__ __forceinline__ float max3f(float a,float b,float c){float r;asm("v_max3_f32 %0, %1, %2, %3":"=v"(r):"v"(a),"v"(b),"v"(c));return r;}
__device__ __forceinline__ float max2f(float a,float b){float r;asm("v_max_f32_e32 %0, %1, %2":"=v"(r):"v"(a),"v"(b));return r;}
__device__ __forceinline__ float fadd_s(float a,float b){float r;asm("v_add_f32_e32 %0, %1, %2":"=v"(r):"v"(a),"v"(b));return r;}
__device__ __forceinline__ float fsub_s(float a,float b){float r;asm("v_sub_f32_e32 %0, %1, %2":"=v"(r):"v"(a),"v"(b));return r;}
typedef float f32x2_t __attribute__((ext_vector_type(2))); typedef __bf16 bf16x2_t __attribute__((ext_vector_type(2)));
__device__ __forceinline__ unsigned cvtpk_s(float lo,float hi){f32x2_t v={lo,hi};bf16x2_t b=__builtin_convertvector(v,bf16x2_t);return __builtin_bit_cast(unsigned,b);}
#define WAIT_BAR(N) asm volatile("s_waitcnt vmcnt(" #N ") lgkmcnt(0)\n\ts_barrier":::"memory")

__device__ __forceinline__ void qkt(f32x16&p0,f32x16&p1,const char*Kslot,const bf16x8*qr,const f32x16&negm,int r32,int hi){
  const char*kb=Kslot+hi*1024+r32*16;
  #pragma unroll
  for(int d0=0;d0<4;++d0){
    const bf16x8 b0=*reinterpret_cast<const bf16x8*>(kb+d0*2048);
    const bf16x8 b1=*reinterpret_cast<const bf16x8*>(kb+d0*2048+512);
    if(d0==0){p0=__builtin_amdgcn_mfma_f32_32x32x16_bf16(b0,qr[0],negm,0,0,0);p1=__builtin_amdgcn_mfma_f32_32x32x16_bf16(b1,qr[0],negm,0,0,0);}
    else{p0=__builtin_amdgcn_mfma_f32_32x32x16_bf16(b0,qr[d0],p0,0,0,0);p1=__builtin_amdgcn_mfma_f32_32x32x16_bf16(b1,qr[d0],p1,0,0,0);}}
}
typedef __attribute__((address_space(3))) const char* lds_cptr;
typedef short v4i16_t __attribute__((ext_vector_type(4)));
__device__ __forceinline__ void kload8(bf16x8*kf,lds_cptr kp){
  kf[0]=*(const __attribute__((address_space(3))) bf16x8*)(kp);      kf[1]=*(const __attribute__((address_space(3))) bf16x8*)(kp+512);
  kf[2]=*(const __attribute__((address_space(3))) bf16x8*)(kp+2048); kf[3]=*(const __attribute__((address_space(3))) bf16x8*)(kp+2560);
  kf[4]=*(const __attribute__((address_space(3))) bf16x8*)(kp+4096); kf[5]=*(const __attribute__((address_space(3))) bf16x8*)(kp+4608);
  kf[6]=*(const __attribute__((address_space(3))) bf16x8*)(kp+6144); kf[7]=*(const __attribute__((address_space(3))) bf16x8*)(kp+6656);
}
__device__ __forceinline__ void kload2(bf16x8*kf,lds_cptr kp,int j){ kf[2*j]=*(const __attribute__((address_space(3))) bf16x8*)(kp+j*2048); kf[2*j+1]=*(const __attribute__((address_space(3))) bf16x8*)(kp+j*2048+512); }
__device__ __forceinline__ s16x4 vtr(lds_cptr p){ return __builtin_bit_cast(s16x4,__builtin_amdgcn_ds_read_tr16_b64_v4i16((__attribute__((address_space(3))) v4i16_t*)p)); }
__device__ __forceinline__ float rowmax(const f32x16&p0,const f32x16&p1){
  float a=max3f(p0[0],p0[1],p1[0]),b=max3f(p0[2],p0[3],p1[1]);a=max3f(a,p1[2],p1[3]);
  #pragma unroll
  for(int r=4;r<16;r+=4){a=max3f(a,p0[r],p0[r+1]);b=max3f(b,p0[r+2],p0[r+3]);a=max3f(a,p1[r],p1[r+1]);b=max3f(b,p1[r+2],p1[r+3]);}
  const float m=max2f(a,b);
  auto rr=__builtin_amdgcn_permlane32_swap(__float_as_uint(m),__float_as_uint(m),false,false);
  return max2f(__uint_as_float(rr[0]),__uint_as_float(rr[1]));
}
__device__ __forceinline__ void pv(f32x16*o,int vb,bf16x8 pa0,bf16x8 pa1,bf16x8 pa2,bf16x8 pa3){
  #pragma unroll
  for(int d0=0;d0<2;++d0){s16x4 lo[4],hi[4];
    #pragma unroll
    for(int ks=0;ks<4;++ks){
      asm volatile("ds_read_b64_tr_b16 %0,%1 offset:%c2":"=&v"(lo[ks]):"v"(vb),"i"(d0*4096+ks*1024):"memory");
      asm volatile("ds_read_b64_tr_b16 %0,%1 offset:%c2":"=&v"(hi[ks]):"v"(vb),"i"(d0*4096+ks*1024+512):"memory");}
    asm volatile("s_waitcnt lgkmcnt(0)":::"memory");SBAR();
    #define PK(k) (bf16x8){lo[k][0],lo[k][1],lo[k][2],lo[k][3],hi[k][0],hi[k][1],hi[k][2],hi[k][3]}
    o[d0]=__builtin_amdgcn_mfma_f32_32x32x16_bf16(pa0,PK(0),o[d0],0,0,0);
    o[d0]=__builtin_amdgcn_mfma_f32_32x32x16_bf16(pa1,PK(1),o[d0],0,0,0);
    o[d0]=__builtin_amdgcn_mfma_f32_32x32x16_bf16(pa2,PK(2),o[d0],0,0,0);
    o[d0]=__builtin_amdgcn_mfma_f32_32x32x16_bf16(pa3,PK(3),o[d0],0,0,0);
    #undef PK
  }
}

#ifndef ATTN_STORE16
#define ATTN_STORE16(p,v) (*(u32x4*)(p)=(v))
#endif
template<int THRL> __device__ __forceinline__ void attn_unit(int b,int vh,int qb,const bf16*Q,const bf16*__restrict__ K,const bf16*__restrict__ V,bf16*O,char*shm,float smax2,bool NOMAX){
  const int qkoff=(vh>>1)*64, voff=(vh>>2)*128+(vh&1)*64;
  const int tid=threadIdx.x,lane=tid&63,r32=lane&31,hi=lane>>5; const int wid=__builtin_amdgcn_readfirstlane(tid>>6);
  const long rowbase=(long)b*SEQ; const int q0=qb*QB;
  const float slope2=__builtin_ldexpf(1.4426950408889634f,-2*((vh>>2)+1));
  int t0; { const float win=(150.f+smax2)/slope2; int tt=(int)floorf(((float)(q0-63)-win)*(1.f/64.f)); tt=tt<0?0:tt; tt&=~1; const int tmax=(q0+QB)/KVBLK-4; tt=tt>tmax?tmax:tt; t0=__builtin_amdgcn_readfirstlane(tt); }
  const long kvbase=rowbase+(long)t0*KVBLK;
  const bf16*Qw=Q+(rowbase+q0+wid*QBLK)*DM+qkoff;
  const bf16*Kh=K+kvbase*DM+qkoff,*Vh=V+kvbase*DM+voff;
  const unsigned lds0=(unsigned)(uintptr_t)shm;
  float*wsf=(float*)(shm+LDS_WS)+wid*64;
  const unsigned koff_=(unsigned)(lane*DM*2), voff_=(unsigned)(((lane>>2)*DM+(lane&3)*8)*2);
  const char*kbase_=(const char*)(Kh+wid*8); const char*vbase_=(const char*)(Vh+(long)(16*(wid&3))*DM+(wid>>2)*32);
  const unsigned kdst=lds0+LDS_K+wid*1024, vdst=lds0+LDS_V+wid*1024;
  #define DMA_K(t,slot) glds16s(kbase_+(long)(t)*(KVBLK*DM*2),koff_,(unsigned)__builtin_amdgcn_readfirstlane(kdst+(slot)))
  #define DMA_V(t,slot) glds16s(vbase_+(long)(t)*(KVBLK*DM*2),voff_,(unsigned)__builtin_amdgcn_readfirstlane(vdst+(slot)))
  const int vb0=(int)(lds0+LDS_V)+((lane>>4)&1)*32+(lane&3)*8+(4*hi+((lane&15)>>2))*64;
  const char*Kbase=shm+LDS_K; bf16x8 kf[8];
  const lds_cptr shm3=(lds_cptr)shm; const lds_cptr kp0=shm3+LDS_K+hi*1024+r32*16; const lds_cptr vp0=shm3+LDS_V+((lane>>4)&1)*32+(lane&3)*8+(4*hi+((lane&15)>>2))*64;
  const int NT=(q0+QB)/KVBLK-t0;
  DMA_K(0,0);DMA_V(0,0);DMA_K(1,SLOTB);
  bf16x8 qr[4];
  #pragma unroll
  for(int d0=0;d0<4;++d0)qr[d0]=*reinterpret_cast<const bf16x8*>(&Qw[(long)r32*DM+d0*16+hi*8]);
  float l_reg=0.f;f32x16 o[2];o[0]=f32x16{};o[1]=f32x16{};f32x16 negm;
  const unsigned esh_=(unsigned)(2*((vh>>2)+1))<<23;
  #define SLC(c) ((c)==0?0.f:__uint_as_float(__float_as_uint(1.4426950408889634f*(float)(c))-esh_))
  float scr_[16];
  #pragma unroll
  for(int r=0;r<16;++r)scr_[r]=SLC((r&3)+8*(r>>2));
  const float s32=SLC(32), s64=SLC(64);
  float cb=slope2*(float)(4*hi+KVBLK*t0-(q0+QB-1));
  #define SETC() do{ _Pragma("unroll") for(int r=0;r<16;++r)negm[r]=cb+scr_[r]; asm volatile("":"+v"(negm)); }while(0)
  #define ADD32(P1) do{ _Pragma("unroll") for(int r=0;r<16;++r)P1[r]+=s32; }while(0)
  SETC();
  const int qrel=wid*QBLK+r32;
  #define CMASK(P0,P1,t) do{int jb_=(t)-(NT-4); if(jb_>=0)cmask(P0,P1,jb_,qrel,hi);}while(0)
  bool resc=false;
  #define START(P0,P1) do{ resc=false; \
    { float dl=slope2*(float)(qrel-(QB-1)); if(!NOMAX){ dl=__builtin_fmaxf(rowmax(P0,P1),dl); } cb=fsub_s(cb,dl); \
      _Pragma("unroll") for(int r=0;r<16;++r){P0[r]=fsub_s(P0[r],dl);P1[r]=fsub_s(P1[r],dl);} \
      cb+=s64; SETC(); } \
    _Pragma("unroll") for(int r=0;r<16;++r)P0[r]=__builtin_amdgcn_exp2f(P0[r]); }while(0)
  #define RESC() do{ if(resc){ asm volatile("s_waitcnt lgkmcnt(0)":::"memory"); \
      _Pragma("unroll") for(int d_=0;d_<2;++d_) _Pragma("unroll") for(int r=0;r<16;++r)o[d_][r]*=wsf[crow(r,hi)]; } }while(0)
  f32x16 pA0,pA1,pB0,pB1;
  int sl_prev=0,sl_cur=0,sl_next=SLOTB;
  #define ROT() do{sl_prev=sl_cur;sl_cur=sl_next;sl_next=(sl_next==(NSLOT-1)*SLOTB)?0:sl_next+SLOTB;}while(0)
  DMA_K(2,2*SLOTB);
  WAIT_BAR(3);
  qkt(pA0,pA1,Kbase,qr,negm,r32,hi);asm volatile("s_nop 15\n\ts_nop 7":"+v"(pA0),"+v"(pA1));ADD32(pA1);CMASK(pA0,pA1,0);
  START(pA0,pA1);
  _Pragma("unroll") for(int r=0;r<16;++r)pA1[r]=__builtin_amdgcn_exp2f(pA1[r]);
  WAIT_BAR(0);
  DMA_K(3,0);DMA_V(1,SLOTB);
  ROT();
  kload8(kf,kp0+sl_cur);
  WAIT_BAR(2);
  s16x4 vlo[8],vhi[8]; u32x4 pw0,pw1,pw2,pw3;
  #define PKW(P,B) cvtpk_s(P[B],P[B+1])
  #define PAF(k) __builtin_bit_cast(bf16x8,pw##k)
  #define VFR(i) (bf16x8){vlo[i][0],vlo[i][1],vlo[i][2],vlo[i][3],vhi[i][0],vhi[i][1],vhi[i][2],vhi[i][3]}
  #define PIN(x) asm volatile("":"+v"(x))
  #define MX3(a,b,c) __builtin_fmaxf(__builtin_fmaxf((a),(b)),(c))
  #define PR2(P,i) __builtin_shufflevector(P,P,i,i+1)
  #define GAPA(MF,Q0,Q1,W0,W1,PW) do{ MF; sacc2+=Q0; sacc2+=Q1; PIN(sacc2); W0; W1; PIN(PW); SBAR(); }while(0)
  #define GAPA1(MF,Q0,W0,W1,PW) do{ MF; sacc2+=Q0; PIN(sacc2); W0; W1; PIN(PW); SBAR(); }while(0)
  #define EX(v) __builtin_amdgcn_exp2f(v)
  #define GAPB(MF,X,B) do{ MF; X[B]=EX(X[B]); X[B+1]=EX(X[B+1]); X[B+2]=EX(X[B+2]); X[B+3]=EX(X[B+3]); PIN(X); SBAR(); }while(0)
  #define VRD(i) do{ vlo[i]=vtr(vp_+(((i)>>2)*4096+((i)&3)*1024)); vhi[i]=vtr(vp_+(((i)>>2)*4096+((i)&3)*1024+512)); }while(0)
  #define KRD(G,j) do{ if(G){ kload2(kf,kp0+sl_next,j); SBAR(); } }while(0)
  #define STEP(C0,C1,P0,P1,t,GK,GV,GL) do{ SBAR(); \
    const lds_cptr vp_=vp0+sl_prev; \
    VRD(0); SBAR(); f32x2_t sacc2=PR2(P0,0); \
    GAPA(C0=__builtin_amdgcn_mfma_f32_32x32x16_bf16(kf[0],qr[0],negm,0,0,0), PR2(P0,2),PR2(P0,4),     pw0[0]=PKW(P0,0), pw0[1]=PKW(P0,2), pw0); \
    VRD(4); SBAR(); GAPA(C1=__builtin_amdgcn_mfma_f32_32x32x16_bf16(kf[1],qr[0],negm,0,0,0), PR2(P0,6),PR2(P0,8),     pw0[2]=PKW(P0,4), pw0[3]=PKW(P0,6), pw0); \
    VRD(1); SBAR(); GAPA(C0=__builtin_amdgcn_mfma_f32_32x32x16_bf16(kf[2],qr[1],C0,0,0,0),   PR2(P0,10),PR2(P0,12), pw1[0]=PKW(P0,8), pw1[1]=PKW(P0,10), pw1); \
    VRD(5); SBAR(); GAPA(C1=__builtin_amdgcn_mfma_f32_32x32x16_bf16(kf[3],qr[1],C1,0,0,0),   PR2(P0,14),PR2(P1,0),   pw1[2]=PKW(P0,12),pw1[3]=PKW(P0,14), pw1); \
    VRD(2); SBAR(); GAPA(C0=__builtin_amdgcn_mfma_f32_32x32x16_bf16(kf[4],qr[2],C0,0,0,0),   PR2(P1,2),PR2(P1,4),     pw2[0]=PKW(P1,0), pw2[1]=PKW(P1,2), pw2); \
    VRD(6); SBAR(); GAPA(C1=__builtin_amdgcn_mfma_f32_32x32x16_bf16(kf[5],qr[2],C1,0,0,0),   PR2(P1,6),PR2(P1,8),     pw2[2]=PKW(P1,4), pw2[3]=PKW(P1,6), pw2); \
    VRD(3); SBAR(); GAPA(C0=__builtin_amdgcn_mfma_f32_32x32x16_bf16(kf[6],qr[3],C0,0,0,0),   PR2(P1,10),PR2(P1,12), pw3[0]=PKW(P1,8), pw3[1]=PKW(P1,10), pw3); \
    VRD(7); SBAR(); GAPA1(C1=__builtin_amdgcn_mfma_f32_32x32x16_bf16(kf[7],qr[3],C1,0,0,0),   PR2(P1,14),       pw3[2]=PKW(P1,12),pw3[3]=PKW(P1,14), pw3); \
    l_reg+=sacc2[0]+sacc2[1]; \
    if(GK){DMA_K((t)+3,sl_cur);} if(GV){DMA_V((t)+1,sl_next);} \
    ADD32(C1); CMASK(C0,C1,t); \
    if(NOMAX){ resc=false; negm=negm+s64; asm volatile("":"+v"(negm)); } else \
    { float a=MX3(C0[0],C0[1],C1[0]),b=MX3(C0[2],C0[3],C1[1]); a=MX3(a,C1[2],C1[3]); \
      _Pragma("unroll") for(int r=4;r<16;r+=4){a=MX3(a,C0[r],C0[r+1]);b=MX3(b,C0[r+2],C0[r+3]);a=MX3(a,C1[r],C1[r+1]);b=MX3(b,C1[r+2],C1[r+3]);} \
      float rm=__builtin_fmaxf(a,b); { auto rr=__builtin_amdgcn_permlane32_swap(__float_as_uint(rm),__float_as_uint(rm),false,false); rm=__builtin_fmaxf(__uint_as_float(rr[0]),__uint_as_float(rr[1])); } \
      resc=false; \
      if(__builtin_expect(__any(rm>(float)THRL),0)){ const float dl=__builtin_fmaxf(rm,0.f); \
        _Pragma("unroll") for(int r=0;r<16;++r){C0[r]-=dl;C1[r]-=dl;} \
        negm=negm-dl; \
        const float f=__builtin_amdgcn_exp2f(-dl); l_reg*=f; if(hi==0)wsf[r32]=f; resc=true; } \
      negm=negm+s64; asm volatile("":"+v"(negm)); } \
    SBAR(); \
    GAPB(o[0]=__builtin_amdgcn_mfma_f32_32x32x16_bf16(PAF(0),VFR(0),o[0],0,0,0), C0,0); \
    GAPB(o[1]=__builtin_amdgcn_mfma_f32_32x32x16_bf16(PAF(0),VFR(4),o[1],0,0,0), C0,4); \
    KRD(GL,0); GAPB(o[0]=__builtin_amdgcn_mfma_f32_32x32x16_bf16(PAF(1),VFR(1),o[0],0,0,0), C0,8); \
    KRD(GL,1); GAPB(o[1]=__builtin_amdgcn_mfma_f32_32x32x16_bf16(PAF(1),VFR(5),o[1],0,0,0), C0,12); \
    KRD(GL,2); GAPB(o[0]=__builtin_amdgcn_mfma_f32_32x32x16_bf16(PAF(2),VFR(2),o[0],0,0,0), C1,0); \
    KRD(GL,3); GAPB(o[1]=__builtin_amdgcn_mfma_f32_32x32x16_bf16(PAF(2),VFR(6),o[1],0,0,0), C1,4); \
    GAPB(o[0]=__builtin_amdgcn_mfma_f32_32x32x16_bf16(PAF(3),VFR(3),o[0],0,0,0), C1,8); \
    GAPB(o[1]=__builtin_amdgcn_mfma_f32_32x32x16_bf16(PAF(3),VFR(7),o[1],0,0,0), C1,12); \
    }while(0)
  int t=1;
  #undef CMASK
  #define CMASK(P0,P1,t) do{}while(0)
  for(;t+5<NT;t+=2){
    STEP(pB0,pB1,pA0,pA1,t,true,true,true);     WAIT_BAR(2); RESC(); ROT();
    STEP(pA0,pA1,pB0,pB1,t+1,true,true,true);   WAIT_BAR(2); RESC(); ROT();
  }
  #undef CMASK
  #define CMASK(P0,P1,t) do{int jb_=(t)-(NT-4); if(jb_>=0)cmask(P0,P1,jb_,qrel,hi);}while(0)
  #define ENDW(tt) do{ if((tt)+3<NT){WAIT_BAR(2);} else if((tt)+2<NT){WAIT_BAR(1);} else {WAIT_BAR(0);} }while(0)
  for(;t+1<NT;t+=2){
    STEP(pB0,pB1,pA0,pA1,t,(t+3<NT),(t+1<NT),(t+1<NT));       ENDW(t);   RESC(); ROT();
    STEP(pA0,pA1,pB0,pB1,t+1,(t+4<NT),(t+2<NT),(t+2<NT));     ENDW(t+1); RESC(); ROT();
  }
  STEP(pB0,pB1,pA0,pA1,NT-1,false,false,false); RESC();
  { float sacc=pB0[0]+pB0[1]; _Pragma("unroll") for(int r=2;r<16;++r)sacc+=pB0[r]; _Pragma("unroll") for(int r=0;r<16;++r)sacc+=pB1[r]; l_reg+=sacc;
    pw0=(u32x4){PKW(pB0,0),PKW(pB0,2),PKW(pB0,4),PKW(pB0,6)};pw1=(u32x4){PKW(pB0,8),PKW(pB0,10),PKW(pB0,12),PKW(pB0,14)};pw2=(u32x4){PKW(pB1,0),PKW(pB1,2),PKW(pB1,4),PKW(pB1,6)};pw3=(u32x4){PKW(pB1,8),PKW(pB1,10),PKW(pB1,12),PKW(pB1,14)};
    SBAR(); pv(o,vb0+sl_cur,PAF(0),PAF(1),PAF(2),PAF(3)); }
  #undef PKW
  #undef PAF
  #undef VFR
  #undef PIN
  #undef MX3
  #undef GAPA
  #undef GAPA1
  #undef PR2
  #undef GAPB
  #undef EX
  #undef VRD
  #undef KRD
  #undef STEP
  #undef ENDW
  const int lane_e=lane, r32e=r32, hie=hi;
  {auto rr=__builtin_amdgcn_permlane32_swap(__float_as_uint(l_reg),__float_as_uint(l_reg),false,false);l_reg=__uint_as_float(rr[0])+__uint_as_float(rr[1]);}
  if(hie==0)wsf[32+r32e]=l_reg;asm volatile("s_waitcnt lgkmcnt(0)":::"memory");
  float rli[16];
  #pragma unroll
  for(int r=0;r<16;++r)rli[r]=__builtin_amdgcn_rcpf(wsf[32+crow(r,hie)]);
  bf16*Ow=O+(rowbase+q0+wid*QBLK)*PO+vh*D;
  { bf16*stg=(bf16*)(shm+LDS_OST)+wid*2048;
    #pragma unroll
    for(int r=0;r<16;++r){const int orow=crow(r,hie);
      #pragma unroll
      for(int d0=0;d0<2;++d0)stg[orow*64+d0*32+r32e]=__float2bfloat16(o[d0][r]*rli[r]);}
    asm volatile("s_waitcnt lgkmcnt(0)":::"memory");
    #pragma unroll
    for(int i=0;i<4;++i){const int row=i*8+(lane_e>>3),ch=lane_e&7; const u32x4 v=*(const u32x4*)(stg+row*64+ch*8); ATTN_STORE16(Ow+(long)row*PO+ch*8,v);} }
  asm volatile("s_waitcnt lgkmcnt(0)\n\ts_barrier":::"memory");
  #undef DMA_K
  #undef DMA_V
  #undef CMASK
  #undef START
  #undef RESC
  #undef ROT
  #undef SETC
  #undef ADD32
}

constexpr int W_LDS_K=0, W_VSLOT=16384, W_LDS_V=3*SLOTB, W_LDS_WS=W_LDS_V+3*W_VSLOT, W_LDS_OST=W_LDS_WS+NW*64*4, W_LDS_BYTES=W_LDS_OST+NW*4096;
__device__ __forceinline__ void attn_wide(int b,int hc,int qb,int split,const bf16*Q,const bf16*__restrict__ K,const bf16*__restrict__ V,bf16*P0,bf16*P1,float*L0,float*L1,char*shm,float smax2){
  const int tid=threadIdx.x,lane=tid&63,r32=lane&31,hi=lane>>5; const int wid=__builtin_amdgcn_readfirstlane(tid>>6);
  const int h=hc>>1; const long rowbase=(long)b*SEQ; const int q0=qb*QB;
  const float slope2=__builtin_ldexpf(1.4426950408889634f,-2*(h+1));
  int t0; { const float win=(150.f+smax2)/slope2; int tt=(int)floorf(((float)(q0-63)-win)*(1.f/64.f)); tt=tt<0?0:tt; tt&=~1; const int tmax=(q0+QB)/KVBLK-4; tt=tt>tmax?tmax:tt; t0=__builtin_amdgcn_readfirstlane(tt); }
  const int NT0=(q0+QB)/KVBLK, NTt=NT0-t0;
  int ta=t0,tb=NT0; bool empty=false;
  if(NTt>64){ const int h0=(NTt>>1)&~1; if(split==0)tb=t0+h0; else ta=t0+h0; } else if(split==1) empty=true;
  bf16*Ow=(split==0?P0:P1)+(rowbase+q0+wid*QBLK)*PO+hc*128;
  float*Lw=(split==0?L0:L1)+(rowbase+q0+wid*QBLK)*8+hc;
  if(empty){
    #pragma unroll
    for(int i=0;i<8;++i){const int row=i*4+(lane>>4),ch=lane&15; *(u32x4*)(Ow+(long)row*PO+ch*8)=(u32x4){0u,0u,0u,0u};}
    if(hi==0)Lw[r32*8]=0.f;
    return; }
  const bf16*Qw=Q+(rowbase+q0+wid*QBLK)*DM+hc*64;
  const bf16*Kh=K+rowbase*DM+hc*64,*Vh=V+rowbase*DM+h*128;
  const unsigned lds0=(unsigned)(uintptr_t)shm;
  float*wsf=(float*)(shm+W_LDS_WS)+wid*64;
  bf16x8 qr[4];
  #pragma unroll
  for(int d0=0;d0<4;++d0)qr[d0]=*reinterpret_cast<const bf16x8*>(&Qw[(long)r32*DM+d0*16+hi*8]);
  const unsigned koff_=(unsigned)(lane*DM*2), voff_=(unsigned)(((lane>>2)*DM+(lane&3)*8)*2);
  const char*kbase_=(const char*)(Kh+wid*8); const char*vbase_=(const char*)(Vh+(long)(16*(wid&3))*DM+(wid>>2)*32);
  const unsigned kdst=lds0+W_LDS_K+wid*1024, vdst=lds0+W_LDS_V+wid*1024;
  #define WDMA(t,sl) do{ glds16s(kbase_+(long)(t)*(KVBLK*DM*2),koff_,(unsigned)__builtin_amdgcn_readfirstlane(kdst+(sl)*SLOTB)); \
      glds16s(vbase_+(long)(t)*(KVBLK*DM*2),voff_,(unsigned)__builtin_amdgcn_readfirstlane(vdst+(sl)*W_VSLOT)); \
      glds16s(vbase_+(long)(t)*(KVBLK*DM*2)+128,voff_,(unsigned)__builtin_amdgcn_readfirstlane(vdst+(sl)*W_VSLOT+8192)); }while(0)
  const int vb0=(int)(lds0+W_LDS_V)+((lane>>4)&1)*32+(lane&3)*8+(4*hi+((lane&15)>>2))*64;
  const int qrel=wid*QBLK+r32;
  const unsigned esh_=(unsigned)(2*(h+1))<<23;
  #define SLC(c) ((c)==0?0.f:__uint_as_float(__float_as_uint(1.4426950408889634f*(float)(c))-esh_))
  f32x16 cini; { const float cb=slope2*(float)(KVBLK*ta+4*hi-q0-qrel);
    #pragma unroll
    for(int r=0;r<16;++r)cini[r]=cb+SLC((r&3)+8*(r>>2)); }
  const float s32=SLC(32), s64=SLC(64);
  f32x16 o[4]; o[0]=f32x16{};o[1]=f32x16{};o[2]=f32x16{};o[3]=f32x16{}; float l_reg=0.f;
  WDMA(ta,0); if(ta+1<tb){WDMA(ta+1,1);}
  int sl=0,sl2=2;
  for(int t=ta;t<tb;++t){
    if(t+1<tb){ asm volatile("s_waitcnt vmcnt(3) lgkmcnt(0)\n\ts_barrier":::"memory"); } else { asm volatile("s_waitcnt vmcnt(0) lgkmcnt(0)\n\ts_barrier":::"memory"); }
    if(t+2<tb){WDMA(t+2,sl2);}
    f32x16 p0,p1;
    qkt(p0,p1,shm+W_LDS_K+sl*SLOTB,qr,cini,r32,hi);
    #pragma unroll
    for(int r=0;r<16;++r)p1[r]+=s32;
    { const int jb_=t-(NT0-4); if(jb_>=0)cmask(p0,p1,jb_,qrel,hi); }
    #pragma unroll
    for(int r=0;r<16;++r){p0[r]=__builtin_amdgcn_exp2f(p0[r]);p1[r]=__builtin_amdgcn_exp2f(p1[r]);}
    { f32x2_t sa=(f32x2_t){p0[0],p0[1]}, sb=(f32x2_t){p1[0],p1[1]};
      #pragma unroll
      for(int r=2;r<16;r+=2){ sa+=(f32x2_t){p0[r],p0[r+1]}; sb+=(f32x2_t){p1[r],p1[r+1]}; }
      l_reg+=(sa[0]+sa[1])+(sb[0]+sb[1]); }
    u32x4 pw0,pw1,pw2,pw3;
    pw0=(u32x4){cvtpk_s(p0[0],p0[1]),cvtpk_s(p0[2],p0[3]),cvtpk_s(p0[4],p0[5]),cvtpk_s(p0[6],p0[7])}; pw1=(u32x4){cvtpk_s(p0[8],p0[9]),cvtpk_s(p0[10],p0[11]),cvtpk_s(p0[12],p0[13]),cvtpk_s(p0[14],p0[15])};
    pw2=(u32x4){cvtpk_s(p1[0],p1[1]),cvtpk_s(p1[2],p1[3]),cvtpk_s(p1[4],p1[5]),cvtpk_s(p1[6],p1[7])}; pw3=(u32x4){cvtpk_s(p1[8],p1[9]),cvtpk_s(p1[10],p1[11]),cvtpk_s(p1[12],p1[13]),cvtpk_s(p1[14],p1[15])};
    pv(o,  vb0+sl*W_VSLOT,     __builtin_bit_cast(bf16x8,pw0),__builtin_bit_cast(bf16x8,pw1),__builtin_bit_cast(bf16x8,pw2),__builtin_bit_cast(bf16x8,pw3));
    pv(o+2,vb0+sl*W_VSLOT+8192,__builtin_bit_cast(bf16x8,pw0),__builtin_bit_cast(bf16x8,pw1),__builtin_bit_cast(bf16x8,pw2),__builtin_bit_cast(bf16x8,pw3));
    cini=cini+s64;
    sl=(sl==2)?0:sl+1; sl2=(sl2==2)?0:sl2+1;
  }
  {auto rr=__builtin_amdgcn_permlane32_swap(__float_as_uint(l_reg),__float_as_uint(l_reg),false,false);l_reg=__uint_as_float(rr[0])+__uint_as_float(rr[1]);}
  if(hi==0)Lw[r32*8]=l_reg;
  bf16*stg=(bf16*)(shm+W_LDS_OST)+wid*2048;
  #pragma unroll
  for(int hf=0;hf<2;++hf){
    #pragma unroll
    for(int r=0;r<16;++r){const int orow=crow(r,hi);
      #pragma unroll
      for(int d0=0;d0<2;++d0)stg[orow*64+d0*32+r32]=__float2bfloat16(o[hf*2+d0][r]);}
    asm volatile("s_waitcnt lgkmcnt(0)":::"memory");
    #pragma unroll
    for(int i=0;i<4;++i){const int row=i*8+(lane>>3),ch=lane&7; const u32x4 v=*(const u32x4*)(stg+row*64+ch*8); *(u32x4*)(Ow+(long)row*PO+hf*64+ch*8)=v;}
    asm volatile("s_waitcnt lgkmcnt(0)":::"memory");
  }
  asm volatile("s_waitcnt lgkmcnt(0)\n\ts_barrier":::"memory");
  #undef WDMA
  #undef SLC
}

constexpr int X_NS=4, X_LDS_K=0, X_VSLOT=16384, X_LDS_V=X_NS*SLOTB, X_LDS_WS=X_LDS_V+X_NS*X_VSLOT, X_LDS_BYTES=X_LDS_WS+NW*64*4;
__device__ __forceinline__ int wide_t0(int q0,int h,float smax2){
  const float slope2=__builtin_ldexpf(1.4426950408889634f,-2*(h+1));
  const float win=(150.f+smax2)/slope2; int tt=(int)floorf(((float)(q0-63)-win)*(1.f/64.f)); tt=tt<0?0:tt; tt&=~1; const int tmax=(q0+QB)/KVBLK-4; return tt>tmax?tmax:tt; }
__device__ __forceinline__ bool wide_cut(int q0,int h,float smax2){ return (q0+QB)/KVBLK-wide_t0(q0,h,smax2)>64; }
__device__ __forceinline__ void attn_wide2(int b,int hc,int qb,int split,const bf16*Q,const bf16*__restrict__ K,const bf16*__restrict__ V,bf16*P0,bf16*P1,float*L0,float*L1,char*shm,float smax2){
  const int tid=threadIdx.x,lane=tid&63,r32=lane&31,hi=lane>>5; const int wid=__builtin_amdgcn_readfirstlane(tid>>6);
  const int h=hc>>1; const long rowbase=(long)b*SEQ; const int q0=qb*QB;
  const float slope2=__builtin_ldexpf(1.4426950408889634f,-2*(h+1));
  int t0; { const float win=(150.f+smax2)/slope2; int tt=(int)floorf(((float)(q0-63)-win)*(1.f/64.f)); tt=tt<0?0:tt; tt&=~1; const int tmax=(q0+QB)/KVBLK-4; tt=tt>tmax?tmax:tt; t0=__builtin_amdgcn_readfirstlane(tt); }
  const int NT0=(q0+QB)/KVBLK, NTt=NT0-t0;
  int ta=t0,tb=NT0; bool empty=false;
  if(NTt>64){ const int h0=(NTt>>1)&~1; if(split==0)tb=t0+h0; else ta=t0+h0; } else if(split==1) empty=true;
  bf16*Ow=(split==0?P0:P1)+(rowbase+q0+wid*QBLK)*PO+hc*128;
  float*Lw=(split==0?L0:L1)+(rowbase+q0+wid*QBLK)*8+hc;
  if(empty)return;
  const bf16*Qw=Q+(rowbase+q0+wid*QBLK)*DM+hc*64;
  const bf16*Kh=K+rowbase*DM+hc*64,*Vh=V+rowbase*DM+h*128;
  const unsigned lds0=(unsigned)(uintptr_t)shm;
  bf16x8 qr[4];
  #pragma unroll
  for(int d0=0;d0<4;++d0)qr[d0]=*reinterpret_cast<const bf16x8*>(&Qw[(long)r32*DM+d0*16+hi*8]);
  const unsigned koff_=(unsigned)(lane*DM*2), voff_=(unsigned)(((lane>>2)*DM+(lane&3)*8)*2);
  const char*kbase_=(const char*)(Kh+wid*8); const char*vbase_=(const char*)(Vh+(long)(16*(wid&3))*DM+(wid>>2)*32);
  const unsigned kdst=lds0+X_LDS_K+wid*1024, vdst=lds0+X_LDS_V+wid*1024;
  #define XDMA(t,sl) do{ glds16s(kbase_+(long)(t)*(KVBLK*DM*2),koff_,(unsigned)__builtin_amdgcn_readfirstlane(kdst+(sl)*SLOTB)); \
      glds16s(vbase_+(long)(t)*(KVBLK*DM*2),voff_,(unsigned)__builtin_amdgcn_readfirstlane(vdst+(sl)*X_VSLOT)); \
      glds16s(vbase_+(long)(t)*(KVBLK*DM*2)+128,voff_,(unsigned)__builtin_amdgcn_readfirstlane(vdst+(sl)*X_VSLOT+8192)); }while(0)
  const lds_cptr shm3=(lds_cptr)shm; const lds_cptr vp0=shm3+X_LDS_V+((lane>>4)&1)*32+(lane&3)*8+(4*hi+((lane&15)>>2))*64;
  const int qrel=wid*QBLK+r32;
  const unsigned esh_=(unsigned)(2*(h+1))<<23;
  #define SLC(c) ((c)==0?0.f:__uint_as_float(__float_as_uint(1.4426950408889634f*(float)(c))-esh_))
  f32x16 cini; { const float cb=slope2*(float)(KVBLK*ta+4*hi-q0-qrel);
    #pragma unroll
    for(int r=0;r<16;++r)cini[r]=cb+SLC((r&3)+8*(r>>2)); }
  const float s32=SLC(32), s64=SLC(64);
  f32x16 o[4]; o[0]=f32x16{};o[1]=f32x16{};o[2]=f32x16{};o[3]=f32x16{}; float l_reg=0.f;
  const int nt=tb-ta;
  XDMA(ta,0); if(nt>1){XDMA(ta+1,1);} if(nt>2){XDMA(ta+2,2);}
  if(nt>2){ asm volatile("s_waitcnt vmcnt(6) lgkmcnt(0)\n\ts_barrier":::"memory"); } else if(nt>1){ asm volatile("s_waitcnt vmcnt(3) lgkmcnt(0)\n\ts_barrier":::"memory"); } else { asm volatile("s_waitcnt vmcnt(0) lgkmcnt(0)\n\ts_barrier":::"memory"); }
  f32x16 pC0,pC1;
  qkt(pC0,pC1,shm+X_LDS_K,qr,cini,r32,hi); cini=cini+s64;
  int sl=0;
  #define EX4(P,B) do{ P[B]=__builtin_amdgcn_exp2f(P[B]); P[B+1]=__builtin_amdgcn_exp2f(P[B+1]); P[B+2]=__builtin_amdgcn_exp2f(P[B+2]); P[B+3]=__builtin_amdgcn_exp2f(P[B+3]); }while(0)
  #define VF(L,H,i) (bf16x8){L[i][0],L[i][1],L[i][2],L[i][3],H[i][0],H[i][1],H[i][2],H[i][3]}
  #define RELD(i) do{ al[i]=vtr(vp_+(8192+((i)>>2)*4096+((i)&3)*1024)); ah[i]=vtr(vp_+(8192+((i)>>2)*4096+((i)&3)*1024+512)); }while(0)
  #define WSTEP(C0_,C1_,N0_,N1_,T_) do{ \
    _Pragma("unroll") \
    for(int r=0;r<16;++r)C1_[r]+=s32; \
    { const int jb_=T_-(NT0-4); if(jb_>=0)cmask(C0_,C1_,jb_,qrel,hi); } \
    if(T_+2<tb){ asm volatile("s_waitcnt vmcnt(3) lgkmcnt(0)\n\ts_barrier":::"memory"); } else { asm volatile("s_waitcnt vmcnt(0) lgkmcnt(0)\n\ts_barrier":::"memory"); } \
    if(T_+3<tb){XDMA(T_+3,(sl+3)&3);} \
    if(T_+1<tb){ \
      const char*kb=shm+X_LDS_K+((sl+1)&3)*SLOTB+hi*1024+r32*16; \
      bf16x8 k0=*reinterpret_cast<const bf16x8*>(kb), k1=*reinterpret_cast<const bf16x8*>(kb+512); \
      _Pragma("unroll") \
      for(int d0=0;d0<4;++d0){ \
        bf16x8 n0=k0,n1=k1; if(d0<3){ n0=*reinterpret_cast<const bf16x8*>(kb+(d0+1)*2048); n1=*reinterpret_cast<const bf16x8*>(kb+(d0+1)*2048+512); } \
        if(d0==0)N0_=__builtin_amdgcn_mfma_f32_32x32x16_bf16(k0,qr[0],cini,0,0,0); else N0_=__builtin_amdgcn_mfma_f32_32x32x16_bf16(k0,qr[d0],N0_,0,0,0); \
        EX4(C0_,4*d0); SBAR(); \
        if(d0==0)N1_=__builtin_amdgcn_mfma_f32_32x32x16_bf16(k1,qr[0],cini,0,0,0); else N1_=__builtin_amdgcn_mfma_f32_32x32x16_bf16(k1,qr[d0],N1_,0,0,0); \
        EX4(C1_,4*d0); SBAR(); \
        k0=n0;k1=n1; } \
      cini=cini+s64; \
    } else { \
      _Pragma("unroll") \
      for(int d0=0;d0<4;++d0){EX4(C0_,4*d0);EX4(C1_,4*d0);} \
    } \
    const lds_cptr vp_=vp0+sl*X_VSLOT; \
    s16x4 al[8],ah[8]; \
    _Pragma("unroll") \
    for(int i=0;i<8;++i){ al[i]=vtr(vp_+((i>>2)*4096+(i&3)*1024)); ah[i]=vtr(vp_+((i>>2)*4096+(i&3)*1024+512)); } \
    { f32x2_t sa=(f32x2_t){C0_[0],C0_[1]}, sb=(f32x2_t){C1_[0],C1_[1]}; \
      _Pragma("unroll") \
      for(int r=2;r<16;r+=2){ sa+=(f32x2_t){C0_[r],C0_[r+1]}; sb+=(f32x2_t){C1_[r],C1_[r+1]}; } \
      l_reg+=(sa[0]+sa[1])+(sb[0]+sb[1]); } \
    u32x4 pw0,pw1,pw2,pw3; \
    pw0=(u32x4){cvtpk_s(C0_[0],C0_[1]),cvtpk_s(C0_[2],C0_[3]),cvtpk_s(C0_[4],C0_[5]),cvtpk_s(C0_[6],C0_[7])}; pw1=(u32x4){cvtpk_s(C0_[8],C0_[9]),cvtpk_s(C0_[10],C0_[11]),cvtpk_s(C0_[12],C0_[13]),cvtpk_s(C0_[14],C0_[15])}; \
    pw2=(u32x4){cvtpk_s(C1_[0],C1_[1]),cvtpk_s(C1_[2],C1_[3]),cvtpk_s(C1_[4],C1_[5]),cvtpk_s(C1_[6],C1_[7])}; pw3=(u32x4){cvtpk_s(C1_[8],C1_[9]),cvtpk_s(C1_[10],C1_[11]),cvtpk_s(C1_[12],C1_[13]),cvtpk_s(C1_[14],C1_[15])}; \
    const bf16x8 pa0=__builtin_bit_cast(bf16x8,pw0),pa1=__builtin_bit_cast(bf16x8,pw1),pa2=__builtin_bit_cast(bf16x8,pw2),pa3=__builtin_bit_cast(bf16x8,pw3); \
    SBAR(); \
    o[0]=__builtin_amdgcn_mfma_f32_32x32x16_bf16(pa0,VF(al,ah,0),o[0],0,0,0); o[1]=__builtin_amdgcn_mfma_f32_32x32x16_bf16(pa0,VF(al,ah,4),o[1],0,0,0); \
    RELD(0); RELD(4); \
    o[0]=__builtin_amdgcn_mfma_f32_32x32x16_bf16(pa1,VF(al,ah,1),o[0],0,0,0); o[1]=__builtin_amdgcn_mfma_f32_32x32x16_bf16(pa1,VF(al,ah,5),o[1],0,0,0); \
    RELD(1); RELD(5); \
    o[0]=__builtin_amdgcn_mfma_f32_32x32x16_bf16(pa2,VF(al,ah,2),o[0],0,0,0); o[1]=__builtin_amdgcn_mfma_f32_32x32x16_bf16(pa2,VF(al,ah,6),o[1],0,0,0); \
    RELD(2); RELD(6); \
    o[0]=__builtin_amdgcn_mfma_f32_32x32x16_bf16(pa3,VF(al,ah,3),o[0],0,0,0); o[1]=__builtin_amdgcn_mfma_f32_32x32x16_bf16(pa3,VF(al,ah,7),o[1],0,0,0); \
    RELD(3); RELD(7); \
    o[2]=__builtin_amdgcn_mfma_f32_32x32x16_bf16(pa0,VF(al,ah,0),o[2],0,0,0); o[3]=__builtin_amdgcn_mfma_f32_32x32x16_bf16(pa0,VF(al,ah,4),o[3],0,0,0); \
    o[2]=__builtin_amdgcn_mfma_f32_32x32x16_bf16(pa1,VF(al,ah,1),o[2],0,0,0); o[3]=__builtin_amdgcn_mfma_f32_32x32x16_bf16(pa1,VF(al,ah,5),o[3],0,0,0); \
    o[2]=__builtin_amdgcn_mfma_f32_32x32x16_bf16(pa2,VF(al,ah,2),o[2],0,0,0); o[3]=__builtin_amdgcn_mfma_f32_32x32x16_bf16(pa2,VF(al,ah,6),o[3],0,0,0); \
    o[2]=__builtin_amdgcn_mfma_f32_32x32x16_bf16(pa3,VF(al,ah,3),o[2],0,0,0); o[3]=__builtin_amdgcn_mfma_f32_32x32x16_bf16(pa3,VF(al,ah,7),o[3],0,0,0); \
    sl=(sl+1)&3; \
  }while(0)
  f32x16 pD0,pD1;
  for(int t=ta;t<tb;t+=2){ WSTEP(pC0,pC1,pD0,pD1,t); WSTEP(pD0,pD1,pC0,pC1,t+1); }
  #undef WSTEP
  #undef RELD
  {auto rr=__builtin_amdgcn_permlane32_swap(__float_as_uint(l_reg),__float_as_uint(l_reg),false,false);l_reg=__uint_as_float(rr[0])+__uint_as_float(rr[1]);}
  { int r32e=r32; asm volatile("":"+v"(r32e)); if(hi==0)Lw[r32e*8]=l_reg; }
  asm volatile("s_waitcnt lgkmcnt(0)\n\ts_barrier":::"memory");
  bf16*stg=(bf16*)(shm+X_LDS_K)+wid*2048;
  #pragma unroll
  for(int hf=0;hf<2;++hf){
    #pragma unroll
    for(int r=0;r<16;++r){const int orow=crow(r,hi);
      #pragma unroll
      for(int d0=0;d0<2;++d0)stg[orow*64+d0*32+r32]=__float2bfloat16(o[hf*2+d0][r]);}
    asm volatile("s_waitcnt lgkmcnt(0)":::"memory");
    #pragma unroll
    for(int i=0;i<4;++i){const int row=i*8+(lane>>3),ch=lane&7; const u32x4 v=*(const u32x4*)(stg+row*64+ch*8); *(u32x4*)(Ow+(long)row*PO+hf*64+ch*8)=v;}
    asm volatile("s_waitcnt lgkmcnt(0)":::"memory");
  }
  asm volatile("s_waitcnt lgkmcnt(0)\n\ts_barrier":::"memory");
  #undef XDMA
  #undef EX4
  #undef VF
}
constexpr int ATTN_LDS_BYTES=LDS_BYTES;
struct AttnTensors { const bf16* Q; const bf16* K; const bf16* V; bf16* O; float smax2; };
struct AttnUnit { int bh; int qb; };
struct StaticOrder {
  int vcu;
  __device__ __forceinline__ explicit StaticOrder(int grid,int block):vcu((block%8)*(grid/8)+block/8){}
  __device__ __forceinline__ bool next(int i,AttnUnit&u)const{ if(i>=4)return false; const int s=vcu&7; u.bh=vcu>>3; u.qb=(i==0)?s:(i==1)?15-s:(i==2)?16+s:31-s; return true; }
  __device__ __forceinline__ void a_ready(const AttnUnit&)const{}
  __device__ __forceinline__ void done(const AttnUnit&)const{}
};
template<class Sched,int THRL=8> __device__ __forceinline__ void attn_phase(char*lds,const AttnTensors&T,const Sched&S){
  AttnUnit u;
  for(int i=0;S.next(i,u);++i){ S.a_ready(u); attn_unit<THRL>(u.bh/NHEAD,u.bh%NHEAD,u.qb,T.Q,T.K,T.V,T.O,lds,T.smax2,false); S.done(u); }
}
#undef SBAR
#undef WAIT_BAR
}
namespace cg = cooperative_groups;
constexpr int NWAVES = 8;
constexpr int M = 16384, D = 1024, FF = 4096, NIN = 4096, SEQ = 8192;
constexpr float EPS = 1e-6f, ONE_MINUS_LINIT = 0.8f, LAMBDA_INIT = 0.2f;
#ifndef MK_N_LAUNCHES
#define MK_N_LAUNCHES 1
#endif
constexpr int N_PHASES = 8;
constexpr size_t MiB = 1u << 20;
constexpr size_t WS_BAR = 4096, WS_CTL_BYTES = 32768;
constexpr size_t WS_CTR = 0;
constexpr size_t WS_WIN = 2 * MiB, WS_WA = 10 * MiB, WS_WB = 11 * MiB, WS_WOUT = 12 * MiB, WS_W1 = 14 * MiB, WS_W2 = 22 * MiB;
constexpr size_t WS_SSQ = 30 * MiB;
constexpr size_t WS_L0 = 31 * MiB, WS_L1 = 31 * MiB + 512 * 1024;
constexpr size_t WS_P1 = 160 * MiB;
constexpr size_t WS_XN = 32 * MiB;
constexpr size_t WS_OV = 32 * MiB;
constexpr size_t WS_MG = 32 * MiB;
constexpr size_t WS_G = 64 * MiB;
constexpr size_t WS_PL = 128 * MiB, WS_ON = 144 * MiB;
constexpr size_t WS_H = 32 * MiB;
constexpr size_t WS_X1B = 160 * MiB;
constexpr size_t WS_Q = 192 * MiB, WS_K = 208 * MiB, WS_V = 224 * MiB, WS_U = 240 * MiB;
constexpr size_t WS_T1 = 192 * MiB;
constexpr size_t WS_END = 256 * MiB;
constexpr int RING_BYTES = 131072, LDS_BYTES = 147456;

#define GAS __attribute__((address_space(1)))
#define LAS __attribute__((address_space(3)))
typedef unsigned short bf16;
typedef unsigned v4u __attribute__((ext_vector_type(4)));
typedef float f32x4 __attribute__((ext_vector_type(4)));
#define LDS_WAIT() asm volatile("s_waitcnt lgkmcnt(0)" ::: "memory")
#define VM_WAIT() asm volatile("s_waitcnt vmcnt(0)" ::: "memory")
__device__ __forceinline__ unsigned f2bf(float f) { unsigned u = __builtin_bit_cast(unsigned, f); return (u + 0x7fffu + ((u >> 16) & 1u)) >> 16; }
__device__ __forceinline__ unsigned pk2(float lo, float hi) { return f2bf(lo) | (f2bf(hi) << 16); }
__device__ __forceinline__ float bflo(unsigned w) { return __uint_as_float(w << 16); }
__device__ __forceinline__ float bfhi(unsigned w) { return __uint_as_float(w & 0xffff0000u); }
__device__ __forceinline__ float wave_sum(float v) {
#pragma unroll
    for (int o = 1; o < 64; o <<= 1) v += __shfl_xor(v, o);
    return v;
}
__device__ __forceinline__ void p0_transpose_item(const float* W, int K, int N, bf16* WT, int ldw, bool permn, const float* rs, int rsmask, float rsmul, LAS float* scr, int item, int lane) {
    const int nblk = N / 32, kb = item / nblk, nb = item % nblk, k0 = 64 * kb, n0 = 32 * nb;
    float wv[32];
#pragma unroll
    for (int i = 0; i < 32; ++i) { const int kk = 2 * i + (lane >> 5); wv[i] = W[(size_t)(k0 + kk) * N + n0 + (lane & 31)]; }
    if (rs) {
#pragma unroll
        for (int i = 0; i < 32; ++i) { const int kk = 2 * i + (lane >> 5); wv[i] *= rs[(k0 + kk) & rsmask] * rsmul; } }
#pragma unroll
    for (int i = 0; i < 32; ++i) { const int kk = 2 * i + (lane >> 5); scr[kk * 33 + (lane & 31)] = wv[i]; }
    LDS_WAIT(); asm volatile("" ::: "memory");
    int n0p = n0; if (permn) { const int ga = (n0 >> 5) & 7; n0p = (n0 & ~255) + 32 * (((ga & 1) << 2) | (ga >> 1)); }
    const int c = lane & 7;
#pragma unroll
    for (int j = 0; j < 4; ++j) { const int n = (lane >> 3) + 8 * j; const LAS float* s = scr + (8 * c) * 33 + n;
        v4u o; o.x = pk2(s[0 * 33], s[1 * 33]); o.y = pk2(s[2 * 33], s[3 * 33]); o.z = pk2(s[4 * 33], s[5 * 33]); o.w = pk2(s[6 * 33], s[7 * 33]);
        *(GAS v4u*)(WT + (size_t)(n0p + n) * ldw + k0 + 8 * c) = o; }
    LDS_WAIT(); asm volatile("" ::: "memory");
}
__device__ __forceinline__ void p0_transpose_item_rt(const float* W, int K, int lgnb, bf16* WT, int ldw, bool has_rs, const float* rs, int rsmask, float rsmul, LAS float* scr, int item, int lane) {
    const int N = 32 << lgnb, kb = item >> lgnb, nb = item & ((1 << lgnb) - 1), k0 = 64 * kb, n0 = 32 * nb;
    float wv[32];
#pragma unroll
    for (int i = 0; i < 32; ++i) { const int kk = 2 * i + (lane >> 5); wv[i] = W[(size_t)(k0 + kk) * N + n0 + (lane & 31)]; }
    if (has_rs) {
#pragma unroll
        for (int i = 0; i < 32; ++i) { const int kk = 2 * i + (lane >> 5); wv[i] *= rs[(k0 + kk) & rsmask] * rsmul; } }
#pragma unroll
    for (int i = 0; i < 32; ++i) { const int kk = 2 * i + (lane >> 5); scr[kk * 33 + (lane & 31)] = wv[i]; }
    LDS_WAIT(); asm volatile("" ::: "memory");
    const int c = lane & 7;
#pragma unroll
    for (int j = 0; j < 4; ++j) { const int n = (lane >> 3) + 8 * j; const LAS float* s = scr + (8 * c) * 33 + n;
        v4u o; o.x = pk2(s[0 * 33], s[1 * 33]); o.y = pk2(s[2 * 33], s[3 * 33]); o.z = pk2(s[4 * 33], s[5 * 33]); o.w = pk2(s[6 * 33], s[7 * 33]);
        *(GAS v4u*)(WT + (size_t)(n0 + n) * ldw + k0 + 8 * c) = o; }
    LDS_WAIT(); asm volatile("" ::: "memory");
}
__device__ __forceinline__ void p0_fold_a_wg(const float* pool_w, const float* pool_scale, const float* wba, bf16* WAt, int item, LAS unsigned char* ldsp, int wave, int lane) {
    const int g = item >> 6, n0 = (item & 63) * 16;
    LAS float* wbs = (LAS float*)ldsp; LAS float* pws = (LAS float*)(ldsp + 8192);
    { float v[4];
#pragma unroll
      for (int i = 0; i < 4; ++i) { const int d = wave * 16 + i * 4 + (lane >> 4); v[i] = pool_scale[g * 128 + d] * wba[(size_t)(g * 128 + d) * 1024 + n0 + (lane & 15)]; }
      f32x4 p[8];
#pragma unroll
      for (int i = 0; i < 8; ++i) p[i] = *(const f32x4*)(pool_w + (size_t)g * 16384 + (size_t)wave * 2048 + i * 256 + lane * 4);
#pragma unroll
      for (int i = 0; i < 4; ++i) wbs[(wave * 16 + i * 4 + (lane >> 4)) * 16 + (lane & 15)] = v[i];
#pragma unroll
      for (int i = 0; i < 8; ++i) *(LAS f32x4*)(pws + wave * 2048 + i * 256 + lane * 4) = p[i]; }
    LDS_WAIT(); __syncthreads();
    { const int c0 = wave * 16 + (lane >> 4) * 4, n = lane & 15;
      float o[4] = {0.f, 0.f, 0.f, 0.f};
#pragma unroll 4
      for (int d = 0; d < 128; d += 4) {
          float w[4];
#pragma unroll
          for (int e = 0; e < 4; ++e) w[e] = wbs[(d + e) * 16 + n];
#pragma unroll
          for (int j = 0; j < 4; ++j) { const f32x4 p = *(const LAS f32x4*)(pws + (c0 + j) * 128 + d); o[j] += (p[0] * w[0] + p[1] * w[1]) + (p[2] * w[2] + p[3] * w[3]); }
      }
      *(GAS unsigned long long*)(WAt + (size_t)(n0 + n) * 1024 + g * 128 + c0) = (unsigned long long)pk2(o[0], o[1]) | ((unsigned long long)pk2(o[2], o[3]) << 32); }
    LDS_WAIT(); __syncthreads();
}
template <int R> __device__ __forceinline__ void rms_rows_to_bf16(const float* x, const float* g, bf16* o, int m0, int stride, int lane) {
    f32x4 v[R][4]; float s[R];
#pragma unroll
    for (int i = 0; i < R; ++i) { const GAS f32x4* xr = (const GAS f32x4*)(x + (size_t)(m0 + i * stride) * D) + lane;
#pragma unroll
        for (int j = 0; j < 4; ++j) v[i][j] = __builtin_nontemporal_load(&xr[64 * j]); }
    f32x4 gg[4];
#pragma unroll
    for (int j = 0; j < 4; ++j) gg[j] = ((const GAS f32x4*)g + lane)[64 * j];
#pragma unroll
    for (int i = 0; i < R; ++i) { s[i] = 0.f;
#pragma unroll
        for (int j = 0; j < 4; ++j) s[i] += (v[i][j].x * v[i][j].x + v[i][j].y * v[i][j].y) + (v[i][j].z * v[i][j].z + v[i][j].w * v[i][j].w); }
#pragma unroll
    for (int of = 1; of < 64; of <<= 1) {
#pragma unroll
        for (int i = 0; i < R; ++i) s[i] += __shfl_xor(s[i], of); }
#pragma unroll
    for (int i = 0; i < R; ++i) { const float r = 1.0f / sqrtf(s[i] * (1.0f / D) + EPS);
        GAS unsigned long long* o8 = (GAS unsigned long long*)(o + (size_t)(m0 + i * stride) * D) + lane;
#pragma unroll
        for (int j = 0; j < 4; ++j) o8[64 * j] = (unsigned long long)pk2(v[i][j].x * r * gg[j].x, v[i][j].y * r * gg[j].y) | ((unsigned long long)pk2(v[i][j].z * r * gg[j].z, v[i][j].w * r * gg[j].w) << 32); }
}
__device__ __forceinline__ void pool_row(const bf16* U, bf16* PL, int m, int lane) {
    const int t = m & (SEQ - 1), w = 2 << (lane >> 4), cnt = (t + 1 < w) ? (t + 1) : w;
    const GAS v4u* up = (const GAS v4u*)(U + (size_t)m * 512) + lane;
    float s[8], x0[8];
    { const v4u q = up[0]; x0[0] = bflo(q.x); x0[1] = bfhi(q.x); x0[2] = bflo(q.y); x0[3] = bfhi(q.y); x0[4] = bflo(q.z); x0[5] = bfhi(q.z); x0[6] = bflo(q.w); x0[7] = bfhi(q.w); }
#pragma unroll
    for (int e = 0; e < 8; ++e) s[e] = x0[e];
    v4u qv[15];
#pragma unroll
    for (int i = 1; i < 16; ++i) qv[i - 1] = up[(i < cnt) ? -64 * i : 0];
#pragma unroll
    for (int i = 1; i < 16; ++i) { const v4u q = qv[i - 1]; const float mk = (i < cnt) ? 1.0f : 0.0f;
        s[0] += mk * bflo(q.x); s[1] += mk * bfhi(q.x); s[2] += mk * bflo(q.y); s[3] += mk * bfhi(q.y); s[4] += mk * bflo(q.z); s[5] += mk * bfhi(q.z); s[6] += mk * bflo(q.w); s[7] += mk * bfhi(q.w); }
    const float ic = 1.0f / (float)cnt;
    v4u o; o.x = pk2(s[0] * ic - x0[0], s[1] * ic - x0[1]); o.y = pk2(s[2] * ic - x0[2], s[3] * ic - x0[3]); o.z = pk2(s[4] * ic - x0[4], s[5] * ic - x0[5]); o.w = pk2(s[6] * ic - x0[6], s[7] * ic - x0[7]);
    *((GAS v4u*)(PL + (size_t)m * 1024) + lane) = o;
}
__device__ __forceinline__ void combine_row(const bf16* OV, bf16* ON, int m, float lam, int lane) {
    const int h = lane >> 4, j8 = (lane & 15) * 8;
    const v4u a = *(const GAS v4u*)(OV + (size_t)m * 1024 + h * 256 + j8), b = *(const GAS v4u*)(OV + (size_t)m * 1024 + h * 256 + 128 + j8);
    float d[8];
    d[0] = bflo(a.x) - lam * bflo(b.x); d[1] = bfhi(a.x) - lam * bfhi(b.x); d[2] = bflo(a.y) - lam * bflo(b.y); d[3] = bfhi(a.y) - lam * bfhi(b.y);
    d[4] = bflo(a.z) - lam * bflo(b.z); d[5] = bfhi(a.z) - lam * bfhi(b.z); d[6] = bflo(a.w) - lam * bflo(b.w); d[7] = bfhi(a.w) - lam * bfhi(b.w);
    float ss = 0.f;
#pragma unroll
    for (int e = 0; e < 8; ++e) ss += d[e] * d[e];
    ss += __shfl_xor(ss, 1); ss += __shfl_xor(ss, 2); ss += __shfl_xor(ss, 4); ss += __shfl_xor(ss, 8);
    const float r = 1.0f / sqrtf(ss * (1.0f / 128.0f) + EPS);
    v4u o; o.x = pk2(d[0] * r, d[1] * r); o.y = pk2(d[2] * r, d[3] * r); o.z = pk2(d[4] * r, d[5] * r); o.w = pk2(d[6] * r, d[7] * r);
    *(GAS v4u*)(ON + (size_t)m * 1024 + 512 + h * 128 + j8) = o;
}
template <int R> __device__ __forceinline__ void combine_wide(const bf16* P0, const bf16* P1, const float* L0, const float* L1, bf16* ON, int m0, int stride, float lam, float smax2, int lane) {
    const int h = lane >> 4, j8 = (lane & 15) * 8;
    v4u a0[R], a1[R], b0[R], b1[R]; float la[R], lb[R];
#pragma unroll
    for (int i = 0; i < R; ++i) { const size_t m = (size_t)(m0 + i * stride), o = m * 1024 + h * 256 + j8;
        const bool cut = attn_body::wide_cut((int)(m & (SEQ - 1)) & ~255, h, smax2);
        a0[i] = *(const GAS v4u*)(P0 + o); b0[i] = *(const GAS v4u*)(P0 + o + 128); la[i] = L0[m * 8 + h * 2]; lb[i] = L0[m * 8 + h * 2 + 1];
        a1[i] = (v4u){0u, 0u, 0u, 0u}; b1[i] = a1[i];
        if (cut) { a1[i] = *(const GAS v4u*)(P1 + o); b1[i] = *(const GAS v4u*)(P1 + o + 128); la[i] += L1[m * 8 + h * 2]; lb[i] += L1[m * 8 + h * 2 + 1]; } }
#pragma unroll
    for (int i = 0; i < R; ++i) {
        const float ia = 1.0f / la[i], ib = lam / lb[i];
        float d[8];
        d[0] = (bflo(a0[i].x) + bflo(a1[i].x)) * ia - (bflo(b0[i].x) + bflo(b1[i].x)) * ib; d[1] = (bfhi(a0[i].x) + bfhi(a1[i].x)) * ia - (bfhi(b0[i].x) + bfhi(b1[i].x)) * ib;
        d[2] = (bflo(a0[i].y) + bflo(a1[i].y)) * ia - (bflo(b0[i].y) + bflo(b1[i].y)) * ib; d[3] = (bfhi(a0[i].y) + bfhi(a1[i].y)) * ia - (bfhi(b0[i].y) + bfhi(b1[i].y)) * ib;
        d[4] = (bflo(a0[i].z) + bflo(a1[i].z)) * ia - (bflo(b0[i].z) + bflo(b1[i].z)) * ib; d[5] = (bfhi(a0[i].z) + bfhi(a1[i].z)) * ia - (bfhi(b0[i].z) + bfhi(b1[i].z)) * ib;
        d[6] = (bflo(a0[i].w) + bflo(a1[i].w)) * ia - (bflo(b0[i].w) + bflo(b1[i].w)) * ib; d[7] = (bfhi(a0[i].w) + bfhi(a1[i].w)) * ia - (bfhi(b0[i].w) + bfhi(b1[i].w)) * ib;
        float ss = 0.f;
#pragma unroll
        for (int e = 0; e < 8; ++e) ss += d[e] * d[e];
        ss += __shfl_xor(ss, 1); ss += __shfl_xor(ss, 2); ss += __shfl_xor(ss, 4); ss += __shfl_xor(ss, 8);
        const float r = 1.0f / sqrtf(ss * (1.0f / 128.0f) + EPS);
        v4u o; o.x = pk2(d[0] * r, d[1] * r); o.y = pk2(d[2] * r, d[3] * r); o.z = pk2(d[4] * r, d[5] * r); o.w = pk2(d[6] * r, d[7] * r);
        *(GAS v4u*)(ON + (size_t)(m0 + i * stride) * 1024 + 512 + h * 128 + j8) = o; }
}
#define XB_TMO      128
#define XB_XCNT(j)  (256  + 64 * (j))
#define XB_XSUB(j)  (1280 + 64 * (j))
#define XB_XGEN(j)  (2304 + 64 * (j))
#define XB_TOP      3328
#define XB_TOPGEN   3392
#define XCD_BAR_WORDS 3456
#define XB_SPIN_CAP (1u << 18)

__device__ __forceinline__ unsigned xb_ld(unsigned* p)              { return __hip_atomic_load(p, __ATOMIC_RELAXED, __HIP_MEMORY_SCOPE_AGENT); }
__device__ __forceinline__ unsigned xb_add(unsigned* p, unsigned v) { return __hip_atomic_fetch_add(p, v, __ATOMIC_RELAXED, __HIP_MEMORY_SCOPE_AGENT); }
__device__ __forceinline__ unsigned xb_xcc_id() { return (unsigned)__builtin_amdgcn_s_getreg((3 << 11) | 20) & 0xFu; }
#define XB_SPIN(cond, bar) do { unsigned _sp = 0; while (cond) { __builtin_amdgcn_s_sleep(1); \
    if ((++_sp & 255u) == 0u) { if (xb_ld(&(bar)[XB_TMO])) break; if (_sp > XB_SPIN_CAP) { atomicAdd(&(bar)[XB_TMO], 1u); break; } } } } while (0)

struct XcdBarrier {
    unsigned* bar; unsigned x;
    volatile LAS unsigned* st;
};

__device__ __forceinline__ XcdBarrier xcd_barrier_post(unsigned* bar, volatile LAS unsigned* st) {
    XcdBarrier b; b.bar = bar; b.x = xb_xcc_id(); b.st = st;
    if (threadIdx.x == 0) (void)xb_add(&bar[XB_XCNT(b.x)], 1u);
    return b;
}
__device__ __forceinline__ void xcd_barrier_complete(unsigned* bar, unsigned x, unsigned& nloc, unsigned& nx) {
    const unsigned G = gridDim.x * gridDim.y * gridDim.z;
    unsigned sum, cnt, mine, sp = 0u;
    for (;;) {
        sum = 0u; cnt = 0u; mine = 0u;
#pragma unroll
        for (unsigned j = 0; j < 16; ++j) { const unsigned c = xb_ld(&bar[XB_XCNT(j)]); sum += c; cnt += (c > 0u) ? 1u : 0u; mine = (j == x) ? c : mine; }
        if (sum == G) break;
        __builtin_amdgcn_s_sleep(1);
        if ((++sp & 255u) == 0u) { if (xb_ld(&bar[XB_TMO])) break; if (sp > XB_SPIN_CAP) { atomicAdd(&bar[XB_TMO], 1u); break; } }
    }
    nloc = mine > 0u ? mine : 1u; nx = cnt > 0u ? cnt : 1u;
}

__device__ __forceinline__ void xcd_barrier(const XcdBarrier& b) {
    asm volatile("s_waitcnt vmcnt(0)" ::: "memory");
    __syncthreads();
    if (threadIdx.x == 0) {
        unsigned* bar = b.bar;
        __builtin_amdgcn_s_waitcnt(0);
        unsigned nloc = b.st[0], nx = b.st[1];
        if (nloc == 0u) { xcd_barrier_complete(bar, b.x, nloc, nx); b.st[0] = nloc; b.st[1] = nx; }
        const unsigned old = xb_add(&bar[XB_XSUB(b.x)], 1u);
        const unsigned gen = old / nloc;
        if (old + 1u == (gen + 1u) * nloc) {
            __builtin_amdgcn_fence(__ATOMIC_RELEASE, "agent");
            asm volatile("s_waitcnt vmcnt(0)" ::: "memory");
            const unsigned og = xb_add(&bar[XB_TOP], 1u);
            const unsigned tg = og / nx;
            if (og + 1u == (tg + 1u) * nx) xb_add(&bar[XB_TOPGEN], 1u);
            else XB_SPIN(xb_ld(&bar[XB_TOPGEN]) == tg, bar);
            __builtin_amdgcn_fence(__ATOMIC_ACQUIRE, "agent");
            xb_add(&bar[XB_XGEN(b.x)], 1u);
            asm volatile("s_waitcnt vmcnt(0)" ::: "memory");
        } else {
            XB_SPIN(xb_ld(&bar[XB_XGEN(b.x)]) == gen, bar);
            __builtin_amdgcn_fence(__ATOMIC_ACQUIRE, "agent");
            asm volatile("s_waitcnt vmcnt(0)" ::: "memory");
        }
    }
    __syncthreads();
}

struct StrideOrder {
    int G, b;
    __device__ __forceinline__ bool next(int i, attn_body::AttnUnit& u) const { const int idx = b + i * G; if (idx >= 1024) return false; u.bh = idx >> 5; u.qb = 31 - (idx & 31); return true; }
    __device__ __forceinline__ void a_ready(const attn_body::AttnUnit&) const {}
    __device__ __forceinline__ void done(const attn_body::AttnUnit&) const {}
};

struct Args { const float* in[19]; float* out; unsigned char* ws; int ph_lo, ph_hi; };
__global__ void __launch_bounds__(NWAVES * 64, 2) fwd_kernel(Args args) {
    extern __shared__ __attribute__((aligned(16))) unsigned char lds[];
    __builtin_assume(__builtin_amdgcn_workitem_id_y() == 0); __builtin_assume(__builtin_amdgcn_workitem_id_z() == 0);
    LAS unsigned char* ldsp = (LAS unsigned char*)lds;
    const int tid = threadIdx.x, lane = tid & 63, wave = __builtin_amdgcn_readfirstlane(tid >> 6);
    const int G = gridDim.x, bx = blockIdx.x;
    const int vcu = (G % 8 == 0) ? (bx % 8) * (G / 8) + bx / 8 : bx;
    const int gw = vcu * NWAVES + wave, NGW = G * NWAVES;
    const int lo = args.ph_lo, hi = args.ph_hi;
    if (lo < 0) cg::this_grid().sync();
    volatile LAS unsigned* bst = (volatile LAS unsigned*)(ldsp + RING_BYTES + 32);
    if (tid == 0) { bst[0] = 0u; bst[1] = 0u; }
    __syncthreads();
    { const __attribute__((address_space(4))) Args* ap0 = (const __attribute__((address_space(4))) Args*)__builtin_amdgcn_kernarg_segment_ptr(); (void)xcd_barrier_post((unsigned*)(ap0->ws + WS_BAR), bst); }
#ifndef PHASE_MASK
#define PHASE_MASK 0xFF
#endif
#define IN(k) (((PHASE_MASK >> (k)) & 1) && lo <= (k) && (k) < hi)
#define SEAM(k) do { if (IN(k) && IN((k) + 1)) { ARGS_RELOAD(); XcdBarrier xb_; xb_.bar = WSP(unsigned, WS_BAR); xb_.x = xb_xcc_id(); xb_.st = bst; xcd_barrier(xb_); } } while (0)
#define ARGS_RELOAD() const __attribute__((address_space(4))) Args* ap = (const __attribute__((address_space(4))) Args*)__builtin_amdgcn_kernarg_segment_ptr(); asm volatile("" : "+s"(ap)); unsigned char* const ws = ap->ws
#define WSP(T, off) ((T*)(ws + (off)))

    if (IN(0)) {
        ARGS_RELOAD();
        LAS float* scr = (LAS float*)(ldsp + wave * 16384);
        constexpr int I_IN = (D / 64) * (NIN / 32);
        for (int it = vcu; it < 256; it += G) p0_fold_a_wg(ap->in[4], ap->in[5], ap->in[13], WSP(bf16, WS_WA), it, ldsp, wave, lane);
        for (int it = gw; it < I_IN; it += NGW) p0_transpose_item(ap->in[2], D, NIN, WSP(bf16, WS_WIN), D, true, nullptr, 0, 1.f, scr, it, lane);
#ifdef PROBE_RMS2
        for (int rep_ = 0; rep_ < 2; ++rep_)
#endif
        for (int m = gw; m + 3 * NGW < M; m += 4 * NGW) rms_rows_to_bf16<4>(ap->in[0], ap->in[1], WSP(bf16, WS_XN), m, NGW, lane);
        for (int m = gw + (M / (4 * NGW)) * 4 * NGW; m < M; m += NGW) rms_rows_to_bf16<1>(ap->in[0], ap->in[1], WSP(bf16, WS_XN), m, NGW, lane);
        VM_WAIT(); __syncthreads();
    }
    SEAM(0);
#ifdef PROBE_SYNC8
    for (int rep_ = 0; rep_ < 8; ++rep_) { ARGS_RELOAD(); XcdBarrier xb_; xb_.bar = WSP(unsigned, WS_BAR); xb_.x = xb_xcc_id(); xb_.st = bst; xcd_barrier(xb_); }
#endif
    if (IN(1)) {
        ARGS_RELOAD();
        pg8::Gemm g{WSP(bf16, WS_XN), WSP(bf16, WS_WIN), M, NIN, D}; pg8::StaticOrder S; S.init(M, NIN, G, bx);
        pg8::EpiIn E{WSP(bf16, WS_U), WSP(bf16, WS_Q), WSP(bf16, WS_K), WSP(bf16, WS_V), WSP(bf16, WS_G), ap->in[6], ap->in[7], ap->in[3]};
        pg8::gemm_phase<pg8::EpiIn, pg8::StaticOrder, true, true>(ldsp, g, S, E);
    }
    SEAM(1);
    if (IN(2)) {
        ARGS_RELOAD();
#ifdef PROBE_POOL2
        for (int rep_ = 0; rep_ < 2; ++rep_)
#endif
        for (int m = gw; m < M; m += NGW) pool_row(WSP(bf16, WS_U), WSP(bf16, WS_PL), m, lane);
        VM_WAIT(); __syncthreads();
        float gq = __builtin_fabsf(ap->in[6][lane]), gk = __builtin_fabsf(ap->in[7][lane]);
#pragma unroll
        for (int o = 1; o < 64; o <<= 1) { gq = __builtin_fmaxf(gq, __shfl_xor(gq, o)); gk = __builtin_fmaxf(gk, __shfl_xor(gk, o)); }
        const float smax2 = pg8::QK_C2 * 64.0f * gq * gk * 1.05f + 1.0f;
        const attn_body::bf16 *Qp = WSP(const attn_body::bf16, WS_Q), *Kp = WSP(const attn_body::bf16, WS_K), *Vp = WSP(const attn_body::bf16, WS_V); attn_body::bf16* Op = WSP(attn_body::bf16, WS_OV);
        unsigned* ctr = WSP(unsigned, WS_CTR);
        const bool nomax = __builtin_amdgcn_readfirstlane(smax2 < 60.0f ? 1 : 0) != 0;
        volatile LAS unsigned* qs = (volatile LAS unsigned*)(ldsp + RING_BYTES + 64);
        int idx2 = 0;
        for (;;) {
            if (tid == 0) *qs = atomicAdd(ctr, 1u);
            __syncthreads();
            const int idx = __builtin_amdgcn_readfirstlane((int)*qs);
            __syncthreads();
            if (idx >= 1024) { idx2 = idx; break; }
            if (nomax) {
                int b_, hc_, qb_, sp_;
                if (idx < 256) { const int r = idx & 15; qb_ = 31 - (idx >> 4); b_ = r >> 3; hc_ = 4 + ((r >> 1) & 3); sp_ = r & 1; }
                else { int j = idx - 256; sp_ = 0; if (j >= 384) { j -= 384; sp_ = 1; }
                    if (j < 128) { const int r = j & 7; qb_ = 15 - (j >> 3); b_ = r >> 2; hc_ = 4 + (r & 3); }
                    else if (j < 256) { j -= 128; const int r = j & 3; qb_ = 31 - (j >> 2); b_ = r >> 1; hc_ = 2 + (r & 1); }
                    else { j -= 256; const int r = j & 3; qb_ = 31 - (j >> 2); b_ = r >> 1; hc_ = r & 1; } }
                attn_body::attn_wide2(b_, hc_, qb_, sp_, Qp, Kp, Vp, Op, WSP(attn_body::bf16, WS_P1), WSP(float, WS_L0), WSP(float, WS_L1), (char*)lds, smax2); }
            else attn_body::attn_unit<8>((idx >> 4) & 1, idx & 15, 31 - (idx >> 5), Qp, Kp, Vp, Op, (char*)lds, smax2, false);
        }
        {   ARGS_RELOAD();
            unsigned* ctr2 = WSP(unsigned, WS_CTR);
            int tid2 = threadIdx.x; asm volatile("" : "+v"(tid2));
            const int lane2 = tid2 & 63, wave2 = __builtin_amdgcn_readfirstlane(tid2 >> 6);
            volatile LAS unsigned* qs2 = (volatile LAS unsigned*)(ldsp + RING_BYTES + 64);
            LAS float* scr2 = (LAS float*)(ldsp + wave2 * 16384);
            constexpr int I_OUT = (D / 64) * (D / 32), I_1 = (D / 64) * (FF / 32), I_2 = (FF / 64) * (D / 32), I_B = (512 / 64) * (D / 32), N_TR = (I_OUT + I_1 + I_2 + I_B) / 32;
            static_assert((I_OUT + I_1 + I_2 + I_B) % 32 == 0, "deferred transposes per workgroup item");
            while (idx2 < 1024 + N_TR) {
                for (int k = 0; k < 4; ++k) { int r = (idx2 - 1024) * 32 + wave2 * 4 + k;
                    const float* W; int K_, lg; bf16* WT; int ldw; bool hrs; const float* rs; int rsmask; float rsmul;
                    if (r < I_OUT) { W = ap->in[15]; K_ = D; lg = 5; WT = WSP(bf16, WS_WOUT); ldw = D; hrs = false; rs = W; rsmask = 0; rsmul = 1.f; }
                    else if (r < I_OUT + I_1) { r -= I_OUT; W = ap->in[17]; K_ = D; lg = 7; WT = WSP(bf16, WS_W1); ldw = D; hrs = true; rs = ap->in[16]; rsmask = 1023; rsmul = 1.f; }
                    else if (r < I_OUT + I_1 + I_2) { r -= I_OUT + I_1; W = ap->in[18]; K_ = FF; lg = 5; WT = WSP(bf16, WS_W2); ldw = FF; hrs = false; rs = W; rsmask = 0; rsmul = 1.f; }
                    else { r -= I_OUT + I_1 + I_2; W = ap->in[14]; K_ = 512; lg = 5; WT = WSP(bf16, WS_WA) + 512; ldw = 1024; hrs = true; rs = ap->in[12]; rsmask = 127; rsmul = ONE_MINUS_LINIT; }
                    p0_transpose_item_rt(W, K_, lg, WT, ldw, hrs, rs, rsmask, rsmul, scr2, r, lane2); }
                if (tid2 == 0) *qs2 = atomicAdd(ctr2, 1u);
                __syncthreads();
                idx2 = __builtin_amdgcn_readfirstlane((int)*qs2);
                __syncthreads();
            }
        }
    }
    SEAM(2);
    if (IN(3)) {
        ARGS_RELOAD();
        const float lam = expf(wave_sum(ap->in[8][lane] * ap->in[9][lane])) - expf(wave_sum(ap->in[10][lane] * ap->in[11][lane])) + LAMBDA_INIT;
        float gq = __builtin_fabsf(ap->in[6][lane]), gk = __builtin_fabsf(ap->in[7][lane]);
#pragma unroll
        for (int o = 1; o < 64; o <<= 1) { gq = __builtin_fmaxf(gq, __shfl_xor(gq, o)); gk = __builtin_fmaxf(gk, __shfl_xor(gk, o)); }
        const float smax2c = pg8::QK_C2 * 64.0f * gq * gk * 1.05f + 1.0f;
        const bool nomax = __builtin_amdgcn_readfirstlane(smax2c < 60.0f ? 1 : 0) != 0;
        if (nomax) { int m = gw; for (; m + 3 * NGW < M; m += 4 * NGW) combine_wide<4>(WSP(bf16, WS_OV), WSP(bf16, WS_P1), WSP(float, WS_L0), WSP(float, WS_L1), WSP(bf16, WS_PL), m, NGW, lam, smax2c, lane);
                     for (; m < M; m += NGW) combine_wide<1>(WSP(bf16, WS_OV), WSP(bf16, WS_P1), WSP(float, WS_L0), WSP(float, WS_L1), WSP(bf16, WS_PL), m, NGW, lam, smax2c, lane); }
        else for (int m = gw; m < M; m += NGW) combine_row(WSP(bf16, WS_OV), WSP(bf16, WS_PL), m, lam, lane);
        VM_WAIT(); __syncthreads();
    }
    SEAM(3);
    if (IN(4)) {
        ARGS_RELOAD();
        pg8::Gemm g{WSP(bf16, WS_PL), WSP(bf16, WS_WA), M, D, 1024}; pg8::StaticOrder S; S.init(M, D, G, bx);
        pg8::EpiMerge E{WSP(bf16, WS_G), WSP(bf16, WS_MG)};
        pg8::gemm_phase<pg8::EpiMerge, pg8::StaticOrder, true, true>(ldsp, g, S, E);
    }
    SEAM(4);
    if (IN(5)) {
        ARGS_RELOAD();
        pg8::Gemm g{WSP(bf16, WS_MG), WSP(bf16, WS_WOUT), M, D, D}; pg8::StaticOrder S; S.init(M, D, G, bx);
        pg8::EpiOut E{ap->in[0], WSP(bf16, WS_X1B), WSP(float, WS_SSQ)};
        pg8::gemm_phase<pg8::EpiOut, pg8::StaticOrder, true, true>(ldsp, g, S, E);
    }
    SEAM(5);
    if (IN(6)) {
        ARGS_RELOAD();
        pg8::Gemm g{WSP(bf16, WS_X1B), WSP(bf16, WS_W1), M, FF, D}; pg8::StaticOrder S; S.init(M, FF, G, bx);
        pg8::Unit u0{-1, 0}; (void)S.next(0, u0);
        LAS float* rtab = (LAS float*)(ldsp + RING_BYTES + 1024);
        if (u0.pm >= 0 && tid < 256) { const f32x4* sp = (const f32x4*)(WSP(float, WS_SSQ) + (size_t)(u0.pm * 256 + tid) * 16); const f32x4 s4 = (sp[0] + sp[1]) + (sp[2] + sp[3]);
            rtab[tid] = __builtin_amdgcn_rsqf(((s4[0] + s4[1]) + (s4[2] + s4[3])) * (1.0f / 1024.0f) + 1e-6f); }
        LDS_WAIT(); __syncthreads();
        pg8::EpiFF1 E{WSP(float, WS_SSQ), WSP(bf16, WS_H), u0.pm, rtab};
        pg8::gemm_phase<pg8::EpiFF1, pg8::StaticOrder, true, true>(ldsp, g, S, E);
    }
    SEAM(6);
    if (IN(7)) {
        ARGS_RELOAD();
        pg8::Gemm g{WSP(bf16, WS_H), WSP(bf16, WS_W2), M, D, FF}; pg8::StaticOrder S; S.init(M, D, G, bx);
        pg8::EpiFF2 E{WSP(bf16, WS_X1B), ap->out};
        pg8::gemm_phase<pg8::EpiFF2, pg8::StaticOrder, true, true>(ldsp, g, S, E);
    }
#undef IN
#undef SEAM
#undef ARGS_RELOAD
#undef WSP
}

#ifdef DBG_STOP
__global__ void dbg_dump(const unsigned short* __restrict__ buf, float* __restrict__ out, size_t n) {
    for (size_t i = (size_t)blockIdx.x * blockDim.x + threadIdx.x; i < n; i += (size_t)gridDim.x * blockDim.x) out[i] = __uint_as_float((unsigned)buf[i] << 16);
}
__global__ void dbg_dump32(const float* __restrict__ buf, float* __restrict__ out, size_t n) {
    for (size_t i = (size_t)blockIdx.x * blockDim.x + threadIdx.x; i < n; i += (size_t)gridDim.x * blockDim.x) out[i] = buf[i];
}
#endif
extern "C" void kernel_launch(void* const* d_in, const int* in_sizes, int n_in, void* d_out, int out_size, void* d_ws, size_t ws_size, hipStream_t stream) {
    static int grid = 0;
    if (grid == 0) {
        if (n_in != 19 || out_size != M * D || ws_size < WS_END) { fprintf(stderr, "kernel_launch: unexpected shapes (n_in %d out %d ws %zu)\n", n_in, out_size, ws_size); grid = -1; return; }
        int dev = 0, cus = 0, per_cu = 0;
        hipGetDevice(&dev); hipDeviceGetAttribute(&cus, hipDeviceAttributeMultiprocessorCount, dev);
        if (hipFuncSetAttribute((const void*)fwd_kernel, hipFuncAttributeMaxDynamicSharedMemorySize, LDS_BYTES) != hipSuccess) { fprintf(stderr, "kernel_launch: hipFuncSetAttribute failed\n"); grid = -1; return; }
        if (hipOccupancyMaxActiveBlocksPerMultiprocessor(&per_cu, (const void*)fwd_kernel, NWAVES * 64, LDS_BYTES) != hipSuccess || per_cu < 1) per_cu = 1;
        (void)hipGetLastError();
        grid = cus * per_cu;
    }
    if (grid < 0) return;
    Args a{};
    for (int i = 0; i < 19; ++i) a.in[i] = (const float*)d_in[i];
    a.out = (float*)d_out; a.ws = (unsigned char*)d_ws;
#if MK_N_LAUNCHES == 1
    void* kargs[] = {&a};
    (void)hipMemsetAsync(d_ws, 0, WS_CTL_BYTES, stream);
#ifdef PROBE_DUP
    a.ph_lo = 0; a.ph_hi = PROBE_DUP_HI;
    (void)hipLaunchCooperativeKernel((const void*)fwd_kernel, dim3(grid), dim3(NWAVES * 64), kargs, LDS_BYTES, stream);
    (void)hipMemsetAsync(d_ws, 0, WS_CTL_BYTES, stream);
    a.ph_lo = PROBE_DUP_LO; a.ph_hi = N_PHASES;
#else
    a.ph_lo = 0; a.ph_hi = N_PHASES;
#endif
    hipError_t e = hipLaunchCooperativeKernel((const void*)fwd_kernel, dim3(grid), dim3(NWAVES * 64), kargs, LDS_BYTES, stream);
    if (e != hipSuccess) fprintf(stderr, "kernel_launch: cooperative launch failed: %s (grid %d)\n", hipGetErrorString(e), grid);
#else
#ifdef DBG_STOP
    for (int p = 0; p <= DBG_STOP; ++p) { a.ph_lo = p; a.ph_hi = p + 1; hipLaunchKernelGGL(fwd_kernel, dim3(grid), dim3(NWAVES * 64), LDS_BYTES, stream, a); }
#ifdef DBG_F32
    hipLaunchKernelGGL(dbg_dump32, dim3(2048), dim3(256), 0, stream, (const float*)((unsigned char*)d_ws + DBG_OFF), (float*)d_out, (size_t)M * D);
#else
    hipLaunchKernelGGL(dbg_dump, dim3(2048), dim3(256), 0, stream, (const unsigned short*)((unsigned char*)d_ws + DBG_OFF), (float*)d_out, (size_t)M * D);
#endif
#else
    for (int p = 0; p < N_PHASES; ++p) { a.ph_lo = p; a.ph_hi = p + 1; hipLaunchKernelGGL(fwd_kernel, dim3(grid), dim3(NWAVES * 64), LDS_BYTES, stream, a); }
#endif
#endif
}
```

```cpp
#include <hip/hip_runtime.h>
#include <hip/hip_cooperative_groups.h>
#include <cstdio>
#include <cstdint>
#include <hip/hip_bf16.h>
#include <cmath>
namespace pg8 {
#define PG8_LAS __attribute__((address_space(3)))
typedef unsigned short bf16_t;
typedef short bf16x8 __attribute__((ext_vector_type(8)));
typedef float f32x4 __attribute__((ext_vector_type(4)));
typedef unsigned u32x4 __attribute__((ext_vector_type(4)));
constexpr int BM = 256, BK = 64, HALF = 128, HTB = HALF * BK * 2  , STAGE_BYTES = 8 * HTB, NXCD = 8, WGM = 8;

__host__ __device__ __forceinline__ int lds_byte(int r, int c) { const int st = (r >> 4) * 2 + (c >> 5), rr = r & 15, cc = c & 31, ob = rr * 64 + cc * 2; return st * 1024 + (ob ^ (((ob >> 9) & 1) << 5)); }
__host__ __device__ __forceinline__ void stage_rc(int b, int& R, int& C) { const int st = b / 1024, sb = b % 1024, swz = sb ^ (((sb >> 9) & 1) << 5); R = (st >> 1) * 16 + swz / 64; C = (st & 1) * 32 + (swz % 64) / 2; }
__host__ __device__ __forceinline__ int perm32(int rho) { const int n = rho >> 4, i = rho & 15; return 8 * (i >> 2) + 4 * n + (i & 3); }

struct Unit { int pm, pn; };
struct Gemm { const bf16_t* A; const bf16_t* Bt; int M, N, K; };

struct StaticOrder {
    int nM, nN, nwg, G, c;
    __host__ __device__ void init(int M, int N, int G_, int c_) { nM = M / BM; nN = N / BM; nwg = nM * nN; G = G_; c = c_; }
    __host__ __device__ bool next(int i, Unit& u) const {
        const long L = (long)i * G + c; if (L >= nwg) return false;
        int wgid = (int)L; { const int q = nwg / NXCD, r = nwg % NXCD, xcd = wgid % NXCD, off = wgid / NXCD; wgid = (xcd < r ? xcd * (q + 1) : r * (q + 1) + (xcd - r) * q) + off; }
        const int nig = WGM * nN, gid = wgid / nig, fm = gid * WGM, gsz = (nM - fm) < WGM ? (nM - fm) : WGM;
        u.pm = fm + ((wgid % nig) % gsz); u.pn = (wgid % nig) / gsz; return true;
    }
    __device__ __forceinline__ void a_ready(const Unit&) const {}
    __device__ __forceinline__ void done(const Unit&) const {}
};

typedef float cvt_f32x2_t __attribute__((ext_vector_type(2))); typedef __bf16 cvt_bf16x2_t __attribute__((ext_vector_type(2)));
__device__ __forceinline__ unsigned cvt_pk_bf16(float lo, float hi) { cvt_f32x2_t v = {lo, hi}; cvt_bf16x2_t b = __builtin_convertvector(v, cvt_bf16x2_t); return __builtin_bit_cast(unsigned, b); }
typedef float f32x2 __attribute__((ext_vector_type(2)));
__device__ __forceinline__ u32x4 pack8(const f32x4 a, const f32x4 b) { u32x4 w; w.x = cvt_pk_bf16(a[0], a[1]); w.y = cvt_pk_bf16(a[2], a[3]); w.z = cvt_pk_bf16(b[0], b[1]); w.w = cvt_pk_bf16(b[2], b[3]); return w; }
__device__ __forceinline__ void unpack8(const u32x4 w, f32x4& a, f32x4& b) {
    a[0] = __uint_as_float(w.x << 16); a[1] = __uint_as_float(w.x & 0xffff0000u); a[2] = __uint_as_float(w.y << 16); a[3] = __uint_as_float(w.y & 0xffff0000u);
    b[0] = __uint_as_float(w.z << 16); b[1] = __uint_as_float(w.z & 0xffff0000u); b[2] = __uint_as_float(w.w << 16); b[3] = __uint_as_float(w.w & 0xffff0000u); }
__device__ __forceinline__ float dot4(const f32x4 x) { return (x[0] * x[0] + x[1] * x[1]) + (x[2] * x[2] + x[3] * x[3]); }
__device__ __forceinline__ f32x4 sigmoid4(const f32x4 x) { f32x4 o;
#pragma unroll
    for (int e = 0; e < 4; ++e) o[e] = __builtin_amdgcn_rcpf(1.0f + __builtin_amdgcn_exp2f(x[e] * -1.4426950408889634f));
    return o; }
constexpr float QK_C2 = 0.125f * 1.4426950408889634f;
struct EpiIn {
    static constexpr bool PERM = true, AFTER_DRAIN = false, HOOK = false, INIT = false;
    bf16_t *U, *Q, *K, *V, *G; const float *qg, *kg, *gb;
    __device__ __forceinline__ void operator()(const f32x4 (&acc)[2][2][4][2], const Unit& u, int wr, int wc, int fr, int fq) const {
        const int pn = u.pn, row0 = u.pm * BM + wr * 64 + fr, cw = 64 * wc + 8 * fq;
        if (pn < 2 || pn == 6 || pn == 7) {
            bf16_t* base = (pn < 2) ? (U + pn * 256) : (V + (pn - 6) * 256);
#pragma unroll
            for (int ai = 0; ai < 2; ++ai)
#pragma unroll
                for (int m = 0; m < 4; ++m) { bf16_t* rowp = base + (size_t)(row0 + ai * HALF + m * 16) * 512 + cw;
#pragma unroll
                    for (int bj = 0; bj < 2; ++bj) *(u32x4*)(rowp + 32 * bj) = pack8(acc[ai][bj][m][0], acc[ai][bj][m][1]); }
        } else if (pn < 6) {
            const bool isq = pn < 4;
            bf16_t* base = isq ? (Q + (pn - 2) * 256) : (K + (pn - 4) * 256);
            const float* g = isq ? qg : kg; const float mul = isq ? QK_C2 : 1.0f;
            f32x4 gv[2][2];
#pragma unroll
            for (int bj = 0; bj < 2; ++bj)
#pragma unroll
                for (int n = 0; n < 2; ++n) gv[bj][n] = *(const f32x4*)(g + 32 * bj + 8 * fq + 4 * n) * mul;
#pragma unroll
            for (int ai = 0; ai < 2; ++ai)
#pragma unroll
                for (int m = 0; m < 4; ++m) { float ss = 0.f;
#pragma unroll
                    for (int bj = 0; bj < 2; ++bj)
#pragma unroll
                        for (int n = 0; n < 2; ++n) ss += dot4(acc[ai][bj][m][n]);
                    ss += __shfl_xor(ss, 16); ss += __shfl_xor(ss, 32);
                    const float r = __builtin_amdgcn_rsqf(ss * (1.0f / 64.0f) + 1e-6f);
                    bf16_t* rowp = base + (size_t)(row0 + ai * HALF + m * 16) * 512 + cw;
#pragma unroll
                    for (int bj = 0; bj < 2; ++bj) *(u32x4*)(rowp + 32 * bj) = pack8(acc[ai][bj][m][0] * r * gv[bj][0], acc[ai][bj][m][1] * r * gv[bj][1]); }
        } else {
            const int gc = (pn - 8) * 256 + cw;
            f32x4 bv[2][2];
#pragma unroll
            for (int bj = 0; bj < 2; ++bj)
#pragma unroll
                for (int n = 0; n < 2; ++n) bv[bj][n] = *(const f32x4*)(gb + gc + 32 * bj + 4 * n);
#pragma unroll
            for (int ai = 0; ai < 2; ++ai)
#pragma unroll
                for (int m = 0; m < 4; ++m) { bf16_t* rowp = G + (size_t)(row0 + ai * HALF + m * 16) * 2048 + gc;
#pragma unroll
                    for (int bj = 0; bj < 2; ++bj) *(u32x4*)(rowp + 32 * bj) = pack8(sigmoid4(acc[ai][bj][m][0] + bv[bj][0]), sigmoid4(acc[ai][bj][m][1] + bv[bj][1])); }
        }
    }
};
struct EpiMerge {
    static constexpr bool PERM = true, AFTER_DRAIN = false, HOOK = true, INIT = false; static constexpr int HOOK_T = 8;
    const bf16_t* G; bf16_t* MG;
    __device__ __forceinline__ void hook(f32x4 (&acc)[2][2][4][2], const Unit& u, int wr, int wc, int fr, int fq) const {
        asm volatile("" : "+v"(fr), "+v"(fq));
        const int row0 = u.pm * BM + wr * 64 + fr, col0 = u.pn * BM + wc * 32 + 8 * fq;
#pragma unroll
        for (int ai = 0; ai < 2; ++ai)
#pragma unroll
            for (int m = 0; m < 4; ++m) { const size_t row = (size_t)(row0 + ai * HALF + m * 16);
#pragma unroll
                for (int bj = 0; bj < 2; ++bj) { const int c = col0 + bj * HALF; f32x4 a0, a1, b0, b1; unpack8(*(const u32x4*)(G + row * 2048 + c), a0, a1); unpack8(*(const u32x4*)(G + row * 2048 + 1024 + c), b0, b1);
#pragma unroll
                    for (int e = 0; e < 4; ++e) { a0[e] *= __builtin_amdgcn_rcpf(__builtin_fmaxf(b0[e], 1e-30f)); a1[e] *= __builtin_amdgcn_rcpf(__builtin_fmaxf(b1[e], 1e-30f)); }
                    acc[ai][bj][m][0] *= a0; acc[ai][bj][m][1] *= a1; }
                if (m == 3) asm volatile("" ::: "memory"); }
    }
    __device__ __forceinline__ void operator()(const f32x4 (&acc)[2][2][4][2], const Unit& u, int wr, int wc, int fr, int fq) const {
        const int row0 = u.pm * BM + wr * 64 + fr, col0 = u.pn * BM + wc * 32 + 8 * fq;
#pragma unroll
        for (int ai = 0; ai < 2; ++ai)
#pragma unroll
            for (int m = 0; m < 4; ++m) { const size_t row = (size_t)(row0 + ai * HALF + m * 16);
#pragma unroll
                for (int bj = 0; bj < 2; ++bj) { const int c = col0 + bj * HALF; f32x4 b0, b1; unpack8(*(const u32x4*)(G + row * 2048 + 1024 + c), b0, b1);
                    *(u32x4*)(MG + row * 1024 + c) = pack8(acc[ai][bj][m][0] * b0, acc[ai][bj][m][1] * b1); } }
    }
};
struct EpiOut {
    static constexpr bool PERM = true, AFTER_DRAIN = false, HOOK = false, INIT = true;
    const float* X; bf16_t* X1B; float* SSQ;
    __device__ __forceinline__ void init(f32x4 (&acc)[2][2][4][2], const Unit& u, int wr, int wc, int fr, int fq) const {
        const int row0 = u.pm * BM + wr * 64 + fr, col0 = u.pn * BM + wc * 32 + 8 * fq;
#pragma unroll
        for (int ai = 0; ai < 2; ++ai)
#pragma unroll
            for (int m = 0; m < 4; ++m) { const size_t row = (size_t)(row0 + ai * HALF + m * 16);
#pragma unroll
                for (int bj = 0; bj < 2; ++bj) { const int c = col0 + bj * HALF; acc[ai][bj][m][0] = __builtin_nontemporal_load((const f32x4*)(X + row * 1024 + c)); acc[ai][bj][m][1] = __builtin_nontemporal_load((const f32x4*)(X + row * 1024 + c + 4)); } }
    }
    __device__ __forceinline__ void operator()(const f32x4 (&acc)[2][2][4][2], const Unit& u, int wr, int wc, int fr, int fq) const {
        const int row0 = u.pm * BM + wr * 64 + fr, col0 = u.pn * BM + wc * 32 + 8 * fq;
#pragma unroll
        for (int ai = 0; ai < 2; ++ai)
#pragma unroll
            for (int m = 0; m < 4; ++m) { const size_t row = (size_t)(row0 + ai * HALF + m * 16); float ss = 0.f;
#pragma unroll
                for (int bj = 0; bj < 2; ++bj) { const int c = col0 + bj * HALF;
                    const f32x4 v0 = acc[ai][bj][m][0], v1 = acc[ai][bj][m][1];
                    *(u32x4*)(X1B + row * 1024 + c) = pack8(v0, v1);
                    ss += dot4(v0) + dot4(v1); }
                ss += __shfl_xor(ss, 16); ss += __shfl_xor(ss, 32);
                if (fq == 0) SSQ[row * 16 + u.pn * 4 + wc] = ss; }
    }
};
struct EpiFF1 {
    static constexpr bool PERM = true, AFTER_DRAIN = false, HOOK = false, INIT = false;
    const float* SSQ; bf16_t* H; int pm_tab; const PG8_LAS float* rtab;
    __device__ __forceinline__ void operator()(const f32x4 (&acc)[2][2][4][2], const Unit& u, int wr, int wc, int fr, int fq) const {
        const int row0 = u.pm * BM + wr * 64 + fr, col0 = u.pn * BM + wc * 32 + 8 * fq;
        const bool tab = (u.pm == pm_tab);
#pragma unroll
        for (int ai = 0; ai < 2; ++ai)
#pragma unroll
            for (int m = 0; m < 4; ++m) { const size_t row = (size_t)(row0 + ai * HALF + m * 16);
                float r;
                if (tab) r = rtab[ai * HALF + wr * 64 + m * 16 + fr];
                else { const f32x4* sp = (const f32x4*)(SSQ + row * 16); const f32x4 s4 = (sp[0] + sp[1]) + (sp[2] + sp[3]);
                    r = __builtin_amdgcn_rsqf(((s4[0] + s4[1]) + (s4[2] + s4[3])) * (1.0f / 1024.0f) + 1e-6f); }
#pragma unroll
                for (int bj = 0; bj < 2; ++bj) { const int c = col0 + bj * HALF; f32x4 v0 = acc[ai][bj][m][0] * r, v1 = acc[ai][bj][m][1] * r;
#pragma unroll
                    for (int e = 0; e < 4; ++e) { v0[e] = __builtin_fmaxf(v0[e], 0.f); v1[e] = __builtin_fmaxf(v1[e], 0.f); }
                    *(u32x4*)(H + row * 4096 + c) = pack8(v0 * v0, v1 * v1); } }
    }
};
struct EpiFF2 {
    static constexpr bool PERM = true, AFTER_DRAIN = false, HOOK = false, INIT = true;
    const bf16_t* X1B; float* OUT;
    __device__ __forceinline__ void init(f32x4 (&acc)[2][2][4][2], const Unit& u, int wr, int wc, int fr, int fq) const {
        const int row0 = u.pm * BM + wr * 64 + fr, col0 = u.pn * BM + wc * 32 + 8 * fq;
#pragma unroll
        for (int ai = 0; ai < 2; ++ai)
#pragma unroll
            for (int m = 0; m < 4; ++m) { const size_t row = (size_t)(row0 + ai * HALF + m * 16);
#pragma unroll
                for (int bj = 0; bj < 2; ++bj) { const int c = col0 + bj * HALF; unpack8(*(const u32x4*)(X1B + row * 1024 + c), acc[ai][bj][m][0], acc[ai][bj][m][1]); } }
    }
    __device__ __forceinline__ void operator()(const f32x4 (&acc)[2][2][4][2], const Unit& u, int wr, int wc, int fr, int fq) const {
        const int row0 = u.pm * BM + wr * 64 + fr, col0 = u.pn * BM + wc * 32 + 8 * fq;
#pragma unroll
        for (int ai = 0; ai < 2; ++ai)
#pragma unroll
            for (int m = 0; m < 4; ++m) { const size_t row = (size_t)(row0 + ai * HALF + m * 16);
#pragma unroll
                for (int bj = 0; bj < 2; ++bj) { float* p = OUT + row * 1024 + col0 + bj * HALF; *(f32x4*)p = acc[ai][bj][m][0]; *(f32x4*)(p + 4) = acc[ai][bj][m][1]; } }
    }
};

template <class Epi, class Sched, bool ALIGN_EPI = false, bool SP2 = false>
__device__ __forceinline__ void gemm_phase(PG8_LAS unsigned char* lds, const Gemm g, const Sched& S, const Epi& E) {
    const int tid = threadIdx.x, wid = __builtin_amdgcn_readfirstlane(tid >> 6), lane = tid & 63, wr = wid >> 2, wc = wid & 3, fr = lane & 15, fq = lane >> 4;
    const int K = g.K, nt = K / BK;
    unsigned voffA[2], voffB[2];
#pragma unroll
    for (int i = 0; i < 2; ++i) { int R, C; stage_rc(tid * 16 + i * 8192, R, C); const int Rb = Epi::PERM ? ((R & ~31) + perm32(R & 31)) : R;
        voffA[i] = (unsigned)(R * K + C) * 2u; voffB[i] = (unsigned)(Rb * K + C) * 2u; }
    const size_t kstep = (size_t)(BK * 2);
    const size_t hstep = (size_t)HALF * K * 2;
    const size_t tstep = 2 * hstep;
    const unsigned ldsw = (unsigned)wid * 1024u;
    const int aoff = lds_byte(wr * 64 + fr, fq * 8), boff = lds_byte(wc * 32 + fr, fq * 8);
#define PG8_SA(b, h) (((b) * 2 + (h)) * HTB)
#define PG8_SB(b, h) ((4 + (b) * 2 + (h)) * HTB)
#define PG8_STAGE(bufoff, gbase, voff) do { _Pragma("unroll") for (int _i = 0; _i < 2; ++_i) \
        __builtin_amdgcn_global_load_lds((const unsigned*)((const char*)(gbase) + (voff)[_i]), (PG8_LAS unsigned*)(lds + (bufoff) + ldsw + _i * 8192), 16, 0, 0); } while (0)
#define PG8_LDA(dst, b, h) do { _Pragma("unroll") for (int m = 0; m < 4; ++m) _Pragma("unroll") for (int k = 0; k < 2; ++k) dst[m][k] = *(const PG8_LAS bf16x8*)(lds + PG8_SA(b, h) + aoff + m * 2048 + k * 1024); } while (0)
#define PG8_LDB(dst, b, h) do { _Pragma("unroll") for (int n = 0; n < 2; ++n) _Pragma("unroll") for (int k = 0; k < 2; ++k) dst[n][k] = *(const PG8_LAS bf16x8*)(lds + PG8_SB(b, h) + boff + n * 2048 + k * 1024); } while (0)
#define PG8_MMA(ai, bj, At, Bt) do { __builtin_amdgcn_s_setprio(1); _Pragma("unroll") for (int m = 0; m < 4; ++m) _Pragma("unroll") for (int n = 0; n < 2; ++n) _Pragma("unroll") for (int k = 0; k < 2; ++k) \
        acc[ai][bj][m][n] = __builtin_amdgcn_mfma_f32_16x16x32_bf16(Bt[n][k], At[m][k], acc[ai][bj][m][n], 0, 0, 0); __builtin_amdgcn_s_setprio(0); } while (0)
#define PG8_WAIT_V(n) asm volatile("s_waitcnt vmcnt(" #n ")" ::: "memory")
#define PG8_WAIT_L(n) asm volatile("s_waitcnt lgkmcnt(" #n ")" ::: "memory")
#define PG8_BAR __builtin_amdgcn_s_barrier()
#define PG8_SCHED __builtin_amdgcn_sched_barrier(0)
    Unit cur, nxt; int ui = 0;
    if (!S.next(0, cur)) return;
    f32x4 acc[2][2][4][2];
    if constexpr (!Epi::INIT) {
#pragma unroll
    for (int a = 0; a < 2; ++a)
#pragma unroll
        for (int b = 0; b < 2; ++b)
#pragma unroll
            for (int m = 0; m < 4; ++m)
#pragma unroll
                for (int n = 0; n < 2; ++n) acc[a][b][m][n] = (f32x4){0.f, 0.f, 0.f, 0.f};
    }
    bf16x8 At[4][2], B0[2][2], B1[2][2];
    const char* cA = (const char*)g.A + (size_t)cur.pm * tstep; const char* cB = (const char*)g.Bt + (size_t)cur.pn * tstep;
    S.a_ready(cur);
    if constexpr (SP2) {
        PG8_STAGE(PG8_SB(0, 0), cB, voffB); PG8_STAGE(PG8_SB(0, 1), cB + hstep, voffB); PG8_STAGE(PG8_SA(0, 0), cA, voffA); PG8_STAGE(PG8_SA(0, 1), cA + hstep, voffA);
        if constexpr (Epi::INIT) E.init(acc, cur, wr, wc, fr, fq);
        if (wr == 1) PG8_BAR;
        PG8_WAIT_V(2); PG8_BAR;
        PG8_STAGE(PG8_SB(1, 0), cB + kstep, voffB); PG8_STAGE(PG8_SA(1, 0), cA + kstep, voffA); PG8_STAGE(PG8_SB(1, 1), cB + hstep + kstep, voffB);
        PG8_WAIT_V(6); PG8_BAR;
    } else {
        PG8_STAGE(PG8_SB(0, 0), cB, voffB); PG8_STAGE(PG8_SA(0, 0), cA, voffA); PG8_STAGE(PG8_SB(0, 1), cB + hstep, voffB); PG8_STAGE(PG8_SA(0, 1), cA + hstep, voffA);
        if constexpr (Epi::INIT) E.init(acc, cur, wr, wc, fr, fq);
        if (wr == 1) PG8_BAR;
        PG8_WAIT_V(4); PG8_BAR;
        PG8_STAGE(PG8_SB(1, 0), cB + kstep, voffB); PG8_STAGE(PG8_SA(1, 0), cA + kstep, voffA); PG8_STAGE(PG8_SB(1, 1), cB + hstep + kstep, voffB);
        PG8_WAIT_V(6); PG8_BAR;
    }
    for (;;) {
        const bool has_next = S.next(ui + 1, nxt);
        const char* nA = has_next ? (const char*)g.A + (size_t)nxt.pm * tstep : cA; const char* nB = has_next ? (const char*)g.Bt + (size_t)nxt.pn * tstep : cB;
        for (int t = 0; t < nt; t += 2) {
            const bool last = (t == nt - 2);
            if constexpr (Epi::HOOK) { if (t == Epi::HOOK_T) E.hook(acc, cur, wr, wc, fr, fq); }
            const char* a1 = cA + (size_t)(t + 1) * kstep;
            const char* a2 = last ? nA : cA + (size_t)(t + 2) * kstep; const char* b2 = last ? nB : cB + (size_t)(t + 2) * kstep;
            const char* a3 = a2 + kstep; const char* b3 = b2 + kstep;
            if (last && has_next) S.a_ready(nxt);
            if constexpr (SP2) {
            PG8_LDB(B0, 0, 0); PG8_LDB(B1, 0, 1); PG8_SCHED; PG8_LDA(At, 0, 0); PG8_STAGE(PG8_SA(1, 1), a1 + hstep, voffA);
            PG8_WAIT_V(8); PG8_WAIT_L(0); PG8_BAR; PG8_MMA(0, 0, At, B0); PG8_MMA(0, 1, At, B1); PG8_BAR; PG8_SCHED;
            PG8_LDA(At, 0, 1); PG8_STAGE(PG8_SB(0, 0), b2, voffB); PG8_STAGE(PG8_SB(0, 1), b2 + hstep, voffB); PG8_STAGE(PG8_SA(0, 0), a2, voffA);
            PG8_WAIT_V(8); PG8_WAIT_L(0); PG8_BAR; PG8_MMA(1, 0, At, B0); PG8_MMA(1, 1, At, B1); PG8_BAR; PG8_SCHED;
            PG8_LDB(B0, 1, 0); PG8_LDB(B1, 1, 1); PG8_SCHED; PG8_LDA(At, 1, 0); PG8_STAGE(PG8_SA(0, 1), a2 + hstep, voffA);
            PG8_WAIT_V(8); PG8_WAIT_L(0); PG8_BAR; PG8_MMA(0, 0, At, B0); PG8_MMA(0, 1, At, B1); PG8_BAR; PG8_SCHED;
            PG8_LDA(At, 1, 1); PG8_STAGE(PG8_SB(1, 0), b3, voffB); PG8_STAGE(PG8_SB(1, 1), b3 + hstep, voffB); PG8_STAGE(PG8_SA(1, 0), a3, voffA);
            PG8_WAIT_V(8); PG8_WAIT_L(0); PG8_BAR; PG8_MMA(1, 0, At, B0); PG8_MMA(1, 1, At, B1); PG8_BAR; PG8_SCHED;
            } else {
            PG8_LDB(B0, 0, 0); PG8_SCHED; PG8_LDA(At, 0, 0); PG8_STAGE(PG8_SA(1, 1), a1 + hstep, voffA);
            PG8_WAIT_L(8); PG8_BAR; PG8_WAIT_L(0); PG8_MMA(0, 0, At, B0); PG8_BAR; PG8_SCHED;
            PG8_LDB(B1, 0, 1); PG8_STAGE(PG8_SB(0, 0), b2, voffB);
            PG8_BAR; PG8_WAIT_L(0); PG8_MMA(0, 1, At, B1); PG8_BAR;
            PG8_LDA(At, 0, 1); PG8_STAGE(PG8_SA(0, 0), a2, voffA);
            PG8_BAR; PG8_WAIT_L(0); PG8_MMA(1, 0, At, B0); PG8_BAR; PG8_SCHED;
            PG8_STAGE(PG8_SB(0, 1), b2 + hstep, voffB);
            PG8_WAIT_V(6); PG8_BAR; PG8_MMA(1, 1, At, B1); PG8_BAR;
            PG8_LDB(B0, 1, 0); PG8_SCHED; PG8_LDA(At, 1, 0); PG8_STAGE(PG8_SA(0, 1), a2 + hstep, voffA);
            PG8_WAIT_L(8); PG8_BAR; PG8_WAIT_L(0); PG8_MMA(0, 0, At, B0); PG8_BAR; PG8_SCHED;
            PG8_LDB(B1, 1, 1); PG8_STAGE(PG8_SB(1, 0), b3, voffB);
            PG8_BAR; PG8_WAIT_L(0); PG8_MMA(0, 1, At, B1); PG8_BAR;
            PG8_LDA(At, 1, 1); PG8_STAGE(PG8_SA(1, 0), a3, voffA);
            PG8_BAR; PG8_WAIT_L(0); PG8_MMA(1, 0, At, B0); PG8_BAR; PG8_SCHED;
            PG8_STAGE(PG8_SB(1, 1), b3 + hstep, voffB);
            PG8_WAIT_V(6); PG8_BAR; PG8_MMA(1, 1, At, B1); PG8_BAR;
            }
        }
        if constexpr (ALIGN_EPI) { if (wr == 0) PG8_BAR; }
        if constexpr (!Epi::AFTER_DRAIN) { E(acc, cur, wr, wc, fr, fq); S.done(cur); }
        if (!has_next) break;
        if constexpr (Epi::INIT) E.init(acc, nxt, wr, wc, fr, fq); else
#pragma unroll
        for (int a = 0; a < 2; ++a)
#pragma unroll
            for (int b = 0; b < 2; ++b)
#pragma unroll
                for (int m = 0; m < 4; ++m)
#pragma unroll
                    for (int n = 0; n < 2; ++n) acc[a][b][m][n] = (f32x4){0.f, 0.f, 0.f, 0.f};
        cur = nxt; cA = nA; cB = nB; ++ui;
        if constexpr (ALIGN_EPI) { if (wr == 1) PG8_BAR; }
    }
    PG8_WAIT_V(0);
    if constexpr (!ALIGN_EPI) { if (wr == 0) PG8_BAR; }
    PG8_BAR;
    if constexpr (Epi::AFTER_DRAIN) { E.fused(acc, cur, wr, wc, fr, fq, lds, wid, lane); S.done(cur); }
#undef PG8_SA
#undef PG8_SB
#undef PG8_STAGE
#undef PG8_LDA
#undef PG8_LDB
#undef PG8_MMA
#undef PG8_WAIT_V
#undef PG8_WAIT_L
#undef PG8_BAR
#undef PG8_SCHED
}
}
namespace attn_body {
using bf16=__hip_bfloat16;
using bf16x8=__attribute__((ext_vector_type(8)))short;
using s16x4=__attribute__((ext_vector_type(4)))short;
using f32x16=__attribute__((ext_vector_type(16)))float;
using u32x4=__attribute__((ext_vector_type(4)))unsigned;
constexpr int BATCH=2,NHEAD=16,SEQ=8192,D=64,DM=512,PO=1024;
constexpr int NW=8,QBLK=32,QB=QBLK*NW,KVBLK=64,NQB=SEQ/QB;
constexpr int ATTN_UNIT_ROWS=QB;
__device__ __forceinline__ int crow(int r,int hi){return (r&3)+8*(r>>2)+4*hi;}
#define SBAR() __builtin_amdgcn_sched_barrier(0)
__device__ __forceinline__ void cmask(f32x16&p0,f32x16&p1,int jb,int qrel,int hi){
  const float NEG=-INFINITY; int kb=64*jb+4*hi;
  #pragma unroll
  for(int r=0;r<16;++r){int kv=kb+(r&3)+8*(r>>2); if(kv>qrel)p0[r]=NEG; if(kv+32>qrel)p1[r]=NEG;}
}

constexpr int NSLOT=3, SLOTB=8192;
constexpr int LDS_K=0, LDS_V=NSLOT*SLOTB, LDS_WS=2*NSLOT*SLOTB, LDS_OST=LDS_WS+NW*64*4, LDS_BYTES=LDS_OST+NW*4096;
constexpr float C2=0.125f*1.4426950408889634f;
__device__ __forceinline__ void glds16(const void*gsrc,unsigned lds_dst){unsigned keep;
  asm volatile("s_mov_b32 %0, m0\n\ts_mov_b32 m0, %2\n\ts_nop 0\n\tglobal_load_lds_dwordx4 %1, off\n\ts_mov_b32 m0, %0":"=&s"(keep):"v"(gsrc),"s"(lds_dst):"memory");}
__device__ __forceinline__ void glds16s(const void*sbase,unsigned voff,unsigned lds_dst){unsigned keep;
  asm volatile("s_mov_b32 %0, m0\n\ts_mov_b32 m0, %3\n\ts_nop 0\n\tglobal_load_lds_dwordx4 %1, %2\n\ts_mov_b32 m0, %0":"=&s"(keep):"v"(voff),"s"(sbase),"s"(lds_dst):"memory");}
__device__ __forceinline__ float max3f(float a,float b,float c){float r;asm("v_max3_f32 %0, %1, %2, %3":"=v"(r):"v"(a),"v"(b),"v"(c));return r;}
__device__ __forceinline__ float max2f(float a,float b){float r;asm("v_max_f32_e32 %0, %1, %2":"=v"(r):"v"(a),"v"(b));return r;}
__device__ __forceinline__ float fadd_s(float a,float b){float r;asm("v_add_f32_e32 %0, %1, %2":"=v"(r):"v"(a),"v"(b));return r;}
__device__ __forceinline__ float fsub_s(float a,float b){float r;asm("v_sub_f32_e32 %0, %1, %2":"=v"(r):"v"(a),"v"(b));return r;}
typedef float f32x2_t __attribute__((ext_vector_type(2))); typedef __bf16 bf16x2_t __attribute__((ext_vector_type(2)));
__device__ __forceinline__ unsigned cvtpk_s(float lo,float hi){f32x2_t v={lo,hi};bf16x2_t b=__builtin_convertvector(v,bf16x2_t);return __builtin_bit_cast(unsigned,b);}
#define WAIT_BAR(N) asm volatile("s_waitcnt vmcnt(" #N ") lgkmcnt(0)\n\ts_barrier":::"memory")

__device__ __forceinline__ void qkt(f32x16&p0,f32x16&p1,const char*Kslot,const bf16x8*qr,const f32x16&negm,int r32,int hi){
  const char*kb=Kslot+hi*1024+r32*16;
  #pragma unroll
  for(int d0=0;d0<4;++d0){
    const bf16x8 b0=*reinterpret_cast<const bf16x8*>(kb+d0*2048);
    const bf16x8 b1=*reinterpret_cast<const bf16x8*>(kb+d0*2048+512);
    if(d0==0){p0=__builtin_amdgcn_mfma_f32_32x32x16_bf16(b0,qr[0],negm,0,0,0);p1=__builtin_amdgcn_mfma_f32_32x32x16_bf16(b1,qr[0],negm,0,0,0);}
    else{p0=__builtin_amdgcn_mfma_f32_32x32x16_bf16(b0,qr[d0],p0,0,0,0);p1=__builtin_amdgcn_mfma_f32_32x32x16_bf16(b1,qr[d0],p1,0,0,0);}}
}
typedef __attribute__((address_space(3))) const char* lds_cptr;
typedef short v4i16_t __attribute__((ext_vector_type(4)));
__device__ __forceinline__ void kload8(bf16x8*kf,lds_cptr kp){
  kf[0]=*(const __attribute__((address_space(3))) bf16x8*)(kp);      kf[1]=*(const __attribute__((address_space(3))) bf16x8*)(kp+512);
  kf[2]=*(const __attribute__((address_space(3))) bf16x8*)(kp+2048); kf[3]=*(const __attribute__((address_space(3))) bf16x8*)(kp+2560);
  kf[4]=*(const __attribute__((address_space(3))) bf16x8*)(kp+4096); kf[5]=*(const __attribute__((address_space(3))) bf16x8*)(kp+4608);
  kf[6]=*(const __attribute__((address_space(3))) bf16x8*)(kp+6144); kf[7]=*(const __attribute__((address_space(3))) bf16x8*)(kp+6656);
}
__device__ __forceinline__ void kload2(bf16x8*kf,lds_cptr kp,int j){ kf[2*j]=*(const __attribute__((address_space(3))) bf16x8*)(kp+j*2048); kf[2*j+1]=*(const __attribute__((address_space(3))) bf16x8*)(kp+j*2048+512); }
__device__ __forceinline__ s16x4 vtr(lds_cptr p){ return __builtin_bit_cast(s16x4,__builtin_amdgcn_ds_read_tr16_b64_v4i16((__attribute__((address_space(3))) v4i16_t*)p)); }
__device__ __forceinline__ float rowmax(const f32x16&p0,const f32x16&p1){
  float a=max3f(p0[0],p0[1],p1[0]),b=max3f(p0[2],p0[3],p1[1]);a=max3f(a,p1[2],p1[3]);
  #pragma unroll
  for(int r=4;r<16;r+=4){a=max3f(a,p0[r],p0[r+1]);b=max3f(b,p0[r+2],p0[r+3]);a=max3f(a,p1[r],p1[r+1]);b=max3f(b,p1[r+2],p1[r+3]);}
  const float m=max2f(a,b);
  auto rr=__builtin_amdgcn_permlane32_swap(__float_as_uint(m),__float_as_uint(m),false,false);
  return max2f(__uint_as_float(rr[0]),__uint_as_float(rr[1]));
}
__device__ __forceinline__ void pv(f32x16*o,int vb,bf16x8 pa0,bf16x8 pa1,bf16x8 pa2,bf16x8 pa3){
  #pragma unroll
  for(int d0=0;d0<2;++d0){s16x4 lo[4],hi[4];
    #pragma unroll
    for(int ks=0;ks<4;++ks){
      asm volatile("ds_read_b64_tr_b16 %0,%1 offset:%c2":"=&v"(lo[ks]):"v"(vb),"i"(d0*4096+ks*1024):"memory");
      asm volatile("ds_read_b64_tr_b16 %0,%1 offset:%c2":"=&v"(hi[ks]):"v"(vb),"i"(d0*4096+ks*1024+512):"memory");}
    asm volatile("s_waitcnt lgkmcnt(0)":::"memory");SBAR();
    #define PK(k) (bf16x8){lo[k][0],lo[k][1],lo[k][2],lo[k][3],hi[k][0],hi[k][1],hi[k][2],hi[k][3]}
    o[d0]=__builtin_amdgcn_mfma_f32_32x32x16_bf16(pa0,PK(0),o[d0],0,0,0);
    o[d0]=__builtin_amdgcn_mfma_f32_32x32x16_bf16(pa1,PK(1),o[d0],0,0,0);
    o[d0]=__builtin_amdgcn_mfma_f32_32x32x16_bf16(pa2,PK(2),o[d0],0,0,0);
    o[d0]=__builtin_amdgcn_mfma_f32_32x32x16_bf16(pa3,PK(3),o[d0],0,0,0);
    #undef PK
  }
}

#ifndef ATTN_STORE16
#define ATTN_STORE16(p,v) (*(u32x4*)(p)=(v))
#endif
template<int THRL> __device__ __forceinline__ void attn_unit(int b,int vh,int qb,const bf16*Q,const bf16*__restrict__ K,const bf16*__restrict__ V,bf16*O,char*shm,float smax2,bool NOMAX){
  const int qkoff=(vh>>1)*64, voff=(vh>>2)*128+(vh&1)*64;
  const int tid=threadIdx.x,lane=tid&63,r32=lane&31,hi=lane>>5; const int wid=__builtin_amdgcn_readfirstlane(tid>>6);
  const long rowbase=(long)b*SEQ; const int q0=qb*QB;
  const float slope2=__builtin_ldexpf(1.4426950408889634f,-2*((vh>>2)+1));
  int t0; { const float win=(150.f+smax2)/slope2; int tt=(int)floorf(((float)(q0-63)-win)*(1.f/64.f)); tt=tt<0?0:tt; tt&=~1; const int tmax=(q0+QB)/KVBLK-4; tt=tt>tmax?tmax:tt; t0=__builtin_amdgcn_readfirstlane(tt); }
  const long kvbase=rowbase+(long)t0*KVBLK;
  const bf16*Qw=Q+(rowbase+q0+wid*QBLK)*DM+qkoff;
  const bf16*Kh=K+kvbase*DM+qkoff,*Vh=V+kvbase*DM+voff;
  const unsigned lds0=(unsigned)(uintptr_t)shm;
  float*wsf=(float*)(shm+LDS_WS)+wid*64;
  const unsigned koff_=(unsigned)(lane*DM*2), voff_=(unsigned)(((lane>>2)*DM+(lane&3)*8)*2);
  const char*kbase_=(const char*)(Kh+wid*8); const char*vbase_=(const char*)(Vh+(long)(16*(wid&3))*DM+(wid>>2)*32);
  const unsigned kdst=lds0+LDS_K+wid*1024, vdst=lds0+LDS_V+wid*1024;
  #define DMA_K(t,slot) glds16s(kbase_+(long)(t)*(KVBLK*DM*2),koff_,(unsigned)__builtin_amdgcn_readfirstlane(kdst+(slot)))
  #define DMA_V(t,slot) glds16s(vbase_+(long)(t)*(KVBLK*DM*2),voff_,(unsigned)__builtin_amdgcn_readfirstlane(vdst+(slot)))
  const int vb0=(int)(lds0+LDS_V)+((lane>>4)&1)*32+(lane&3)*8+(4*hi+((lane&15)>>2))*64;
  const char*Kbase=shm+LDS_K; bf16x8 kf[8];
  const lds_cptr shm3=(lds_cptr)shm; const lds_cptr kp0=shm3+LDS_K+hi*1024+r32*16; const lds_cptr vp0=shm3+LDS_V+((lane>>4)&1)*32+(lane&3)*8+(4*hi+((lane&15)>>2))*64;
  const int NT=(q0+QB)/KVBLK-t0;
  DMA_K(0,0);DMA_V(0,0);DMA_K(1,SLOTB);
  bf16x8 qr[4];
  #pragma unroll
  for(int d0=0;d0<4;++d0)qr[d0]=*reinterpret_cast<const bf16x8*>(&Qw[(long)r32*DM+d0*16+hi*8]);
  float l_reg=0.f;f32x16 o[2];o[0]=f32x16{};o[1]=f32x16{};f32x16 negm;
  const unsigned esh_=(unsigned)(2*((vh>>2)+1))<<23;
  #define SLC(c) ((c)==0?0.f:__uint_as_float(__float_as_uint(1.4426950408889634f*(float)(c))-esh_))
  float scr_[16];
  #pragma unroll
  for(int r=0;r<16;++r)scr_[r]=SLC((r&3)+8*(r>>2));
  const float s32=SLC(32), s64=SLC(64);
  float cb=slope2*(float)(4*hi+KVBLK*t0-(q0+QB-1));
  #define SETC() do{ _Pragma("unroll") for(int r=0;r<16;++r)negm[r]=cb+scr_[r]; asm volatile("":"+v"(negm)); }while(0)
  #define ADD32(P1) do{ _Pragma("unroll") for(int r=0;r<16;++r)P1[r]+=s32; }while(0)
  SETC();
  const int qrel=wid*QBLK+r32;
  #define CMASK(P0,P1,t) do{int jb_=(t)-(NT-4); if(jb_>=0)cmask(P0,P1,jb_,qrel,hi);}while(0)
  bool resc=false;
  #define START(P0,P1) do{ resc=false; \
    { float dl=slope2*(float)(qrel-(QB-1)); if(!NOMAX){ dl=__builtin_fmaxf(rowmax(P0,P1),dl); } cb=fsub_s(cb,dl); \
      _Pragma("unroll") for(int r=0;r<16;++r){P0[r]=fsub_s(P0[r],dl);P1[r]=fsub_s(P1[r],dl);} \
      cb+=s64; SETC(); } \
    _Pragma("unroll") for(int r=0;r<16;++r)P0[r]=__builtin_amdgcn_exp2f(P0[r]); }while(0)
  #define RESC() do{ if(resc){ asm volatile("s_waitcnt lgkmcnt(0)":::"memory"); \
      _Pragma("unroll") for(int d_=0;d_<2;++d_) _Pragma("unroll") for(int r=0;r<16;++r)o[d_][r]*=wsf[crow(r,hi)]; } }while(0)
  f32x16 pA0,pA1,pB0,pB1;
  int sl_prev=0,sl_cur=0,sl_next=SLOTB;
  #define ROT() do{sl_prev=sl_cur;sl_cur=sl_next;sl_next=(sl_next==(NSLOT-1)*SLOTB)?0:sl_next+SLOTB;}while(0)
  DMA_K(2,2*SLOTB);
  WAIT_BAR(3);
  qkt(pA0,pA1,Kbase,qr,negm,r32,hi);asm volatile("s_nop 15\n\ts_nop 7":"+v"(pA0),"+v"(pA1));ADD32(pA1);CMASK(pA0,pA1,0);
  START(pA0,pA1);
  _Pragma("unroll") for(int r=0;r<16;++r)pA1[r]=__builtin_amdgcn_exp2f(pA1[r]);
  WAIT_BAR(0);
  DMA_K(3,0);DMA_V(1,SLOTB);
  ROT();
  kload8(kf,kp0+sl_cur);
  WAIT_BAR(2);
  s16x4 vlo[8],vhi[8]; u32x4 pw0,pw1,pw2,pw3;
  #define PKW(P,B) cvtpk_s(P[B],P[B+1])
  #define PAF(k) __builtin_bit_cast(bf16x8,pw##k)
  #define VFR(i) (bf16x8){vlo[i][0],vlo[i][1],vlo[i][2],vlo[i][3],vhi[i][0],vhi[i][1],vhi[i][2],vhi[i][3]}
  #define PIN(x) asm volatile("":"+v"(x))
  #define MX3(a,b,c) __builtin_fmaxf(__builtin_fmaxf((a),(b)),(c))
  #define PR2(P,i) __builtin_shufflevector(P,P,i,i+1)
  #define GAPA(MF,Q0,Q1,W0,W1,PW) do{ MF; sacc2+=Q0; sacc2+=Q1; PIN(sacc2); W0; W1; PIN(PW); SBAR(); }while(0)
  #define GAPA1(MF,Q0,W0,W1,PW) do{ MF; sacc2+=Q0; PIN(sacc2); W0; W1; PIN(PW); SBAR(); }while(0)
  #define EX(v) __builtin_amdgcn_exp2f(v)
  #define GAPB(MF,X,B) do{ MF; X[B]=EX(X[B]); X[B+1]=EX(X[B+1]); X[B+2]=EX(X[B+2]); X[B+3]=EX(X[B+3]); PIN(X); SBAR(); }while(0)
  #define VRD(i) do{ vlo[i]=vtr(vp_+(((i)>>2)*4096+((i)&3)*1024)); vhi[i]=vtr(vp_+(((i)>>2)*4096+((i)&3)*1024+512)); }while(0)
  #define KRD(G,j) do{ if(G){ kload2(kf,kp0+sl_next,j); SBAR(); } }while(0)
  #define STEP(C0,C1,P0,P1,t,GK,GV,GL) do{ SBAR(); \
    const lds_cptr vp_=vp0+sl_prev; \
    VRD(0); SBAR(); f32x2_t sacc2=PR2(P0,0); \
    GAPA(C0=__builtin_amdgcn_mfma_f32_32x32x16_bf16(kf[0],qr[0],negm,0,0,0), PR2(P0,2),PR2(P0,4),     pw0[0]=PKW(P0,0), pw0[1]=PKW(P0,2), pw0); \
    VRD(4); SBAR(); GAPA(C1=__builtin_amdgcn_mfma_f32_32x32x16_bf16(kf[1],qr[0],negm,0,0,0), PR2(P0,6),PR2(P0,8),     pw0[2]=PKW(P0,4), pw0[3]=PKW(P0,6), pw0); \
    VRD(1); SBAR(); GAPA(C0=__builtin_amdgcn_mfma_f32_32x32x16_bf16(kf[2],qr[1],C0,0,0,0),   PR2(P0,10),PR2(P0,12), pw1[0]=PKW(P0,8), pw1[1]=PKW(P0,10), pw1); \
    VRD(5); SBAR(); GAPA(C1=__builtin_amdgcn_mfma_f32_32x32x16_bf16(kf[3],qr[1],C1,0,0,0),   PR2(P0,14),PR2(P1,0),   pw1[2]=PKW(P0,12),pw1[3]=PKW(P0,14), pw1); \
    VRD(2); SBAR(); GAPA(C0=__builtin_amdgcn_mfma_f32_32x32x16_bf16(kf[4],qr[2],C0,0,0,0),   PR2(P1,2),PR2(P1,4),     pw2[0]=PKW(P1,0), pw2[1]=PKW(P1,2), pw2); \
    VRD(6); SBAR(); GAPA(C1=__builtin_amdgcn_mfma_f32_32x32x16_bf16(kf[5],qr[2],C1,0,0,0),   PR2(P1,6),PR2(P1,8),     pw2[2]=PKW(P1,4), pw2[3]=PKW(P1,6), pw2); \
    VRD(3); SBAR(); GAPA(C0=__builtin_amdgcn_mfma_f32_32x32x16_bf16(kf[6],qr[3],C0,0,0,0),   PR2(P1,10),PR2(P1,12), pw3[0]=PKW(P1,8), pw3[1]=PKW(P1,10), pw3); \
    VRD(7); SBAR(); GAPA1(C1=__builtin_amdgcn_mfma_f32_32x32x16_bf16(kf[7],qr[3],C1,0,0,0),   PR2(P1,14),       pw3[2]=PKW(P1,12),pw3[3]=PKW(P1,14), pw3); \
    l_reg+=sacc2[0]+sacc2[1]; \
    if(GK){DMA_K((t)+3,sl_cur);} if(GV){DMA_V((t)+1,sl_next);} \
    ADD32(C1); CMASK(C0,C1,t); \
    if(NOMAX){ resc=false; negm=negm+s64; asm volatile("":"+v"(negm)); } else \
    { float a=MX3(C0[0],C0[1],C1[0]),b=MX3(C0[2],C0[3],C1[1]); a=MX3(a,C1[2],C1[3]); \
      _Pragma("unroll") for(int r=4;r<16;r+=4){a=MX3(a,C0[r],C0[r+1]);b=MX3(b,C0[r+2],C0[r+3]);a=MX3(a,C1[r],C1[r+1]);b=MX3(b,C1[r+2],C1[r+3]);} \
      float rm=__builtin_fmaxf(a,b); { auto rr=__builtin_amdgcn_permlane32_swap(__float_as_uint(rm),__float_as_uint(rm),false,false); rm=__builtin_fmaxf(__uint_as_float(rr[0]),__uint_as_float(rr[1])); } \
      resc=false; \
      if(__builtin_expect(__any(rm>(float)THRL),0)){ const float dl=__builtin_fmaxf(rm,0.f); \
        _Pragma("unroll") for(int r=0;r<16;++r){C0[r]-=dl;C1[r]-=dl;} \
        negm=negm-dl; \
        const float f=__builtin_amdgcn_exp2f(-dl); l_reg*=f; if(hi==0)wsf[r32]=f; resc=true; } \
      negm=negm+s64; asm volatile("":"+v"(negm)); } \
    SBAR(); \
    GAPB(o[0]=__builtin_amdgcn_mfma_f32_32x32x16_bf16(PAF(0),VFR(0),o[0],0,0,0), C0,0); \
    GAPB(o[1]=__builtin_amdgcn_mfma_f32_32x32x16_bf16(PAF(0),VFR(4),o[1],0,0,0), C0,4); \
    KRD(GL,0); GAPB(o[0]=__builtin_amdgcn_mfma_f32_32x32x16_bf16(PAF(1),VFR(1),o[0],0,0,0), C0,8); \
    KRD(GL,1); GAPB(o[1]=__builtin_amdgcn_mfma_f32_32x32x16_bf16(PAF(1),VFR(5),o[1],0,0,0), C0,12); \
    KRD(GL,2); GAPB(o[0]=__builtin_amdgcn_mfma_f32_32x32x16_bf16(PAF(2),VFR(2),o[0],0,0,0), C1,0); \
    KRD(GL,3); GAPB(o[1]=__builtin_amdgcn_mfma_f32_32x32x16_bf16(PAF(2),VFR(6),o[1],0,0,0), C1,4); \
    GAPB(o[0]=__builtin_amdgcn_mfma_f32_32x32x16_bf16(PAF(3),VFR(3),o[0],0,0,0), C1,8); \
    GAPB(o[1]=__builtin_amdgcn_mfma_f32_32x32x16_bf16(PAF(3),VFR(7),o[1],0,0,0), C1,12); \
    }while(0)
  int t=1;
  #undef CMASK
  #define CMASK(P0,P1,t) do{}while(0)
  for(;t+5<NT;t+=2){
    STEP(pB0,pB1,pA0,pA1,t,true,true,true);     WAIT_BAR(2); RESC(); ROT();
    STEP(pA0,pA1,pB0,pB1,t+1,true,true,true);   WAIT_BAR(2); RESC(); ROT();
  }
  #undef CMASK
  #define CMASK(P0,P1,t) do{int jb_=(t)-(NT-4); if(jb_>=0)cmask(P0,P1,jb_,qrel,hi);}while(0)
  #define ENDW(tt) do{ if((tt)+3<NT){WAIT_BAR(2);} else if((tt)+2<NT){WAIT_BAR(1);} else {WAIT_BAR(0);} }while(0)
  for(;t+1<NT;t+=2){
    STEP(pB0,pB1,pA0,pA1,t,(t+3<NT),(t+1<NT),(t+1<NT));       ENDW(t);   RESC(); ROT();
    STEP(pA0,pA1,pB0,pB1,t+1,(t+4<NT),(t+2<NT),(t+2<NT));     ENDW(t+1); RESC(); ROT();
  }
  STEP(pB0,pB1,pA0,pA1,NT-1,false,false,false); RESC();
  { float sacc=pB0[0]+pB0[1]; _Pragma("unroll") for(int r=2;r<16;++r)sacc+=pB0[r]; _Pragma("unroll") for(int r=0;r<16;++r)sacc+=pB1[r]; l_reg+=sacc;
    pw0=(u32x4){PKW(pB0,0),PKW(pB0,2),PKW(pB0,4),PKW(pB0,6)};pw1=(u32x4){PKW(pB0,8),PKW(pB0,10),PKW(pB0,12),PKW(pB0,14)};pw2=(u32x4){PKW(pB1,0),PKW(pB1,2),PKW(pB1,4),PKW(pB1,6)};pw3=(u32x4){PKW(pB1,8),PKW(pB1,10),PKW(pB1,12),PKW(pB1,14)};
    SBAR(); pv(o,vb0+sl_cur,PAF(0),PAF(1),PAF(2),PAF(3)); }
  #undef PKW
  #undef PAF
  #undef VFR
  #undef PIN
  #undef MX3
  #undef GAPA
  #undef GAPA1
  #undef PR2
  #undef GAPB
  #undef EX
  #undef VRD
  #undef KRD
  #undef STEP
  #undef ENDW
  const int lane_e=lane, r32e=r32, hie=hi;
  {auto rr=__builtin_amdgcn_permlane32_swap(__float_as_uint(l_reg),__float_as_uint(l_reg),false,false);l_reg=__uint_as_float(rr[0])+__uint_as_float(rr[1]);}
  if(hie==0)wsf[32+r32e]=l_reg;asm volatile("s_waitcnt lgkmcnt(0)":::"memory");
  float rli[16];
  #pragma unroll
  for(int r=0;r<16;++r)rli[r]=__builtin_amdgcn_rcpf(wsf[32+crow(r,hie)]);
  bf16*Ow=O+(rowbase+q0+wid*QBLK)*PO+vh*D;
  { bf16*stg=(bf16*)(shm+LDS_OST)+wid*2048;
    #pragma unroll
    for(int r=0;r<16;++r){const int orow=crow(r,hie);
      #pragma unroll
      for(int d0=0;d0<2;++d0)stg[orow*64+d0*32+r32e]=__float2bfloat16(o[d0][r]*rli[r]);}
    asm volatile("s_waitcnt lgkmcnt(0)":::"memory");
    #pragma unroll
    for(int i=0;i<4;++i){const int row=i*8+(lane_e>>3),ch=lane_e&7; const u32x4 v=*(const u32x4*)(stg+row*64+ch*8); ATTN_STORE16(Ow+(long)row*PO+ch*8,v);} }
  asm volatile("s_waitcnt lgkmcnt(0)\n\ts_barrier":::"memory");
  #undef DMA_K
  #undef DMA_V
  #undef CMASK
  #undef START
  #undef RESC
  #undef ROT
  #undef SETC
  #undef ADD32
}

constexpr int W_LDS_K=0, W_VSLOT=16384, W_LDS_V=3*SLOTB, W_LDS_WS=W_LDS_V+3*W_VSLOT, W_LDS_OST=W_LDS_WS+NW*64*4, W_LDS_BYTES=W_LDS_OST+NW*4096;
__device__ __forceinline__ void attn_wide(int b,int hc,int qb,int split,const bf16*Q,const bf16*__restrict__ K,const bf16*__restrict__ V,bf16*P0,bf16*P1,float*L0,float*L1,char*shm,float smax2){
  const int tid=threadIdx.x,lane=tid&63,r32=lane&31,hi=lane>>5; const int wid=__builtin_amdgcn_readfirstlane(tid>>6);
  const int h=hc>>1; const long rowbase=(long)b*SEQ; const int q0=qb*QB;
  const float slope2=__builtin_ldexpf(1.4426950408889634f,-2*(h+1));
  int t0; { const float win=(150.f+smax2)/slope2; int tt=(int)floorf(((float)(q0-63)-win)*(1.f/64.f)); tt=tt<0?0:tt; tt&=~1; const int tmax=(q0+QB)/KVBLK-4; tt=tt>tmax?tmax:tt; t0=__builtin_amdgcn_readfirstlane(tt); }
  const int NT0=(q0+QB)/KVBLK, NTt=NT0-t0;
  int ta=t0,tb=NT0; bool empty=false;
  if(NTt>64){ const int h0=(NTt>>1)&~1; if(split==0)tb=t0+h0; else ta=t0+h0; } else if(split==1) empty=true;
  bf16*Ow=(split==0?P0:P1)+(rowbase+q0+wid*QBLK)*PO+hc*128;
  float*Lw=(split==0?L0:L1)+(rowbase+q0+wid*QBLK)*8+hc;
  if(empty){
    #pragma unroll
    for(int i=0;i<8;++i){const int row=i*4+(lane>>4),ch=lane&15; *(u32x4*)(Ow+(long)row*PO+ch*8)=(u32x4){0u,0u,0u,0u};}
    if(hi==0)Lw[r32*8]=0.f;
    return; }
  const bf16*Qw=Q+(rowbase+q0+wid*QBLK)*DM+hc*64;
  const bf16*Kh=K+rowbase*DM+hc*64,*Vh=V+rowbase*DM+h*128;
  const unsigned lds0=(unsigned)(uintptr_t)shm;
  float*wsf=(float*)(shm+W_LDS_WS)+wid*64;
  bf16x8 qr[4];
  #pragma unroll
  for(int d0=0;d0<4;++d0)qr[d0]=*reinterpret_cast<const bf16x8*>(&Qw[(long)r32*DM+d0*16+hi*8]);
  const unsigned koff_=(unsigned)(lane*DM*2), voff_=(unsigned)(((lane>>2)*DM+(lane&3)*8)*2);
  const char*kbase_=(const char*)(Kh+wid*8); const char*vbase_=(const char*)(Vh+(long)(16*(wid&3))*DM+(wid>>2)*32);
  const unsigned kdst=lds0+W_LDS_K+wid*1024, vdst=lds0+W_LDS_V+wid*1024;
  #define WDMA(t,sl) do{ glds16s(kbase_+(long)(t)*(KVBLK*DM*2),koff_,(unsigned)__builtin_amdgcn_readfirstlane(kdst+(sl)*SLOTB)); \
      glds16s(vbase_+(long)(t)*(KVBLK*DM*2),voff_,(unsigned)__builtin_amdgcn_readfirstlane(vdst+(sl)*W_VSLOT)); \
      glds16s(vbase_+(long)(t)*(KVBLK*DM*2)+128,voff_,(unsigned)__builtin_amdgcn_readfirstlane(vdst+(sl)*W_VSLOT+8192)); }while(0)
  const int vb0=(int)(lds0+W_LDS_V)+((lane>>4)&1)*32+(lane&3)*8+(4*hi+((lane&15)>>2))*64;
  const int qrel=wid*QBLK+r32;
  const unsigned esh_=(unsigned)(2*(h+1))<<23;
  #define SLC(c) ((c)==0?0.f:__uint_as_float(__float_as_uint(1.4426950408889634f*(float)(c))-esh_))
  f32x16 cini; { const float cb=slope2*(float)(KVBLK*ta+4*hi-q0-qrel);
    #pragma unroll
    for(int r=0;r<16;++r)cini[r]=cb+SLC((r&3)+8*(r>>2)); }
  const float s32=SLC(32), s64=SLC(64);
  f32x16 o[4]; o[0]=f32x16{};o[1]=f32x16{};o[2]=f32x16{};o[3]=f32x16{}; float l_reg=0.f;
  WDMA(ta,0); if(ta+1<tb){WDMA(ta+1,1);}
  int sl=0,sl2=2;
  for(int t=ta;t<tb;++t){
    if(t+1<tb){ asm volatile("s_waitcnt vmcnt(3) lgkmcnt(0)\n\ts_barrier":::"memory"); } else { asm volatile("s_waitcnt vmcnt(0) lgkmcnt(0)\n\ts_barrier":::"memory"); }
    if(t+2<tb){WDMA(t+2,sl2);}
    f32x16 p0,p1;
    qkt(p0,p1,shm+W_LDS_K+sl*SLOTB,qr,cini,r32,hi);
    #pragma unroll
    for(int r=0;r<16;++r)p1[r]+=s32;
    { const int jb_=t-(NT0-4); if(jb_>=0)cmask(p0,p1,jb_,qrel,hi); }
    #pragma unroll
    for(int r=0;r<16;++r){p0[r]=__builtin_amdgcn_exp2f(p0[r]);p1[r]=__builtin_amdgcn_exp2f(p1[r]);}
    { f32x2_t sa=(f32x2_t){p0[0],p0[1]}, sb=(f32x2_t){p1[0],p1[1]};
      #pragma unroll
      for(int r=2;r<16;r+=2){ sa+=(f32x2_t){p0[r],p0[r+1]}; sb+=(f32x2_t){p1[r],p1[r+1]}; }
      l_reg+=(sa[0]+sa[1])+(sb[0]+sb[1]); }
    u32x4 pw0,pw1,pw2,pw3;
    pw0=(u32x4){cvtpk_s(p0[0],p0[1]),cvtpk_s(p0[2],p0[3]),cvtpk_s(p0[4],p0[5]),cvtpk_s(p0[6],p0[7])}; pw1=(u32x4){cvtpk_s(p0[8],p0[9]),cvtpk_s(p0[10],p0[11]),cvtpk_s(p0[12],p0[13]),cvtpk_s(p0[14],p0[15])};
    pw2=(u32x4){cvtpk_s(p1[0],p1[1]),cvtpk_s(p1[2],p1[3]),cvtpk_s(p1[4],p1[5]),cvtpk_s(p1[6],p1[7])}; pw3=(u32x4){cvtpk_s(p1[8],p1[9]),cvtpk_s(p1[10],p1[11]),cvtpk_s(p1[12],p1[13]),cvtpk_s(p1[14],p1[15])};
    pv(o,  vb0+sl*W_VSLOT,     __builtin_bit_cast(bf16x8,pw0),__builtin_bit_cast(bf16x8,pw1),__builtin_bit_cast(bf16x8,pw2),__builtin_bit_cast(bf16x8,pw3));
    pv(o+2,vb0+sl*W_VSLOT+8192,__builtin_bit_cast(bf16x8,pw0),__builtin_bit_cast(bf16x8,pw1),__builtin_bit_cast(bf16x8,pw2),__builtin_bit_cast(bf16x8,pw3));
    cini=cini+s64;
    sl=(sl==2)?0:sl+1; sl2=(sl2==2)?0:sl2+1;
  }
  {auto rr=__builtin_amdgcn_permlane32_swap(__float_as_uint(l_reg),__float_as_uint(l_reg),false,false);l_reg=__uint_as_float(rr[0])+__uint_as_float(rr[1]);}
  if(hi==0)Lw[r32*8]=l_reg;
  bf16*stg=(bf16*)(shm+W_LDS_OST)+wid*2048;
  #pragma unroll
  for(int hf=0;hf<2;++hf){
    #pragma unroll
    for(int r=0;r<16;++r){const int orow=crow(r,hi);
      #pragma unroll
      for(int d0=0;d0<2;++d0)stg[orow*64+d0*32+r32]=__float2bfloat16(o[hf*2+d0][r]);}
    asm volatile("s_waitcnt lgkmcnt(0)":::"memory");
    #pragma unroll
    for(int i=0;i<4;++i){const int row=i*8+(lane>>3),ch=lane&7; const u32x4 v=*(const u32x4*)(stg+row*64+ch*8); *(u32x4*)(Ow+(long)row*PO+hf*64+ch*8)=v;}
    asm volatile("s_waitcnt lgkmcnt(0)":::"memory");
  }
  asm volatile("s_waitcnt lgkmcnt(0)\n\ts_barrier":::"memory");
  #undef WDMA
  #undef SLC
}

constexpr int X_NS=4, X_LDS_K=0, X_VSLOT=16384, X_LDS_V=X_NS*SLOTB, X_LDS_WS=X_LDS_V+X_NS*X_VSLOT, X_LDS_BYTES=X_LDS_WS+NW*64*4;
__device__ __forceinline__ int wide_t0(int q0,int h,float smax2){
  const float slope2=__builtin_ldexpf(1.4426950408889634f,-2*(h+1));
  const float win=(150.f+smax2)/slope2; int tt=(int)floorf(((float)(q0-63)-win)*(1.f/64.f)); tt=tt<0?0:tt; tt&=~1; const int tmax=(q0+QB)/KVBLK-4; return tt>tmax?tmax:tt; }
__device__ __forceinline__ bool wide_cut(int q0,int h,float smax2){ return (q0+QB)/KVBLK-wide_t0(q0,h,smax2)>64; }
__device__ __forceinline__ void attn_wide2(int b,int hc,int qb,int split,const bf16*Q,const bf16*__restrict__ K,const bf16*__restrict__ V,bf16*P0,bf16*P1,float*L0,float*L1,char*shm,float smax2){
  const int tid=threadIdx.x,lane=tid&63,r32=lane&31,hi=lane>>5; const int wid=__builtin_amdgcn_readfirstlane(tid>>6);
  const int h=hc>>1; const long rowbase=(long)b*SEQ; const int q0=qb*QB;
  const float slope2=__builtin_ldexpf(1.4426950408889634f,-2*(h+1));
  int t0; { const float win=(150.f+smax2)/slope2; int tt=(int)floorf(((float)(q0-63)-win)*(1.f/64.f)); tt=tt<0?0:tt; tt&=~1; const int tmax=(q0+QB)/KVBLK-4; tt=tt>tmax?tmax:tt; t0=__builtin_amdgcn_readfirstlane(tt); }
  const int NT0=(q0+QB)/KVBLK, NTt=NT0-t0;
  int ta=t0,tb=NT0; bool empty=false;
  if(NTt>64){ const int h0=(NTt>>1)&~1; if(split==0)tb=t0+h0; else ta=t0+h0; } else if(split==1) empty=true;
  bf16*Ow=(split==0?P0:P1)+(rowbase+q0+wid*QBLK)*PO+hc*128;
  float*Lw=(split==0?L0:L1)+(rowbase+q0+wid*QBLK)*8+hc;
  if(empty)return;
  const bf16*Qw=Q+(rowbase+q0+wid*QBLK)*DM+hc*64;
  const bf16*Kh=K+rowbase*DM+hc*64,*Vh=V+rowbase*DM+h*128;
  const unsigned lds0=(unsigned)(uintptr_t)shm;
  bf16x8 qr[4];
  #pragma unroll
  for(int d0=0;d0<4;++d0)qr[d0]=*reinterpret_cast<const bf16x8*>(&Qw[(long)r32*DM+d0*16+hi*8]);
  const unsigned koff_=(unsigned)(lane*DM*2), voff_=(unsigned)(((lane>>2)*DM+(lane&3)*8)*2);
  const char*kbase_=(const char*)(Kh+wid*8); const char*vbase_=(const char*)(Vh+(long)(16*(wid&3))*DM+(wid>>2)*32);
  const unsigned kdst=lds0+X_LDS_K+wid*1024, vdst=lds0+X_LDS_V+wid*1024;
  #define XDMA(t,sl) do{ glds16s(kbase_+(long)(t)*(KVBLK*DM*2),koff_,(unsigned)__builtin_amdgcn_readfirstlane(kdst+(sl)*SLOTB)); \
      glds16s(vbase_+(long)(t)*(KVBLK*DM*2),voff_,(unsigned)__builtin_amdgcn_readfirstlane(vdst+(sl)*X_VSLOT)); \
      glds16s(vbase_+(long)(t)*(KVBLK*DM*2)+128,voff_,(unsigned)__builtin_amdgcn_readfirstlane(vdst+(sl)*X_VSLOT+8192)); }while(0)
  const lds_cptr shm3=(lds_cptr)shm; const lds_cptr vp0=shm3+X_LDS_V+((lane>>4)&1)*32+(lane&3)*8+(4*hi+((lane&15)>>2))*64;
  const int qrel=wid*QBLK+r32;
  const unsigned esh_=(unsigned)(2*(h+1))<<23;
  #define SLC(c) ((c)==0?0.f:__uint_as_float(__float_as_uint(1.4426950408889634f*(float)(c))-esh_))
  f32x16 cini; { const float cb=slope2*(float)(KVBLK*ta+4*hi-q0-qrel);
    #pragma unroll
    for(int r=0;r<16;++r)cini[r]=cb+SLC((r&3)+8*(r>>2)); }
  const float s32=SLC(32), s64=SLC(64);
  f32x16 o[4]; o[0]=f32x16{};o[1]=f32x16{};o[2]=f32x16{};o[3]=f32x16{}; float l_reg=0.f;
  const int nt=tb-ta;
  XDMA(ta,0); if(nt>1){XDMA(ta+1,1);} if(nt>2){XDMA(ta+2,2);}
  if(nt>2){ asm volatile("s_waitcnt vmcnt(6) lgkmcnt(0)\n\ts_barrier":::"memory"); } else if(nt>1){ asm volatile("s_waitcnt vmcnt(3) lgkmcnt(0)\n\ts_barrier":::"memory"); } else { asm volatile("s_waitcnt vmcnt(0) lgkmcnt(0)\n\ts_barrier":::"memory"); }
  f32x16 pC0,pC1;
  qkt(pC0,pC1,shm+X_LDS_K,qr,cini,r32,hi); cini=cini+s64;
  int sl=0;
  #define EX4(P,B) do{ P[B]=__builtin_amdgcn_exp2f(P[B]); P[B+1]=__builtin_amdgcn_exp2f(P[B+1]); P[B+2]=__builtin_amdgcn_exp2f(P[B+2]); P[B+3]=__builtin_amdgcn_exp2f(P[B+3]); }while(0)
  #define VF(L,H,i) (bf16x8){L[i][0],L[i][1],L[i][2],L[i][3],H[i][0],H[i][1],H[i][2],H[i][3]}
  #define RELD(i) do{ al[i]=vtr(vp_+(8192+((i)>>2)*4096+((i)&3)*1024)); ah[i]=vtr(vp_+(8192+((i)>>2)*4096+((i)&3)*1024+512)); }while(0)
  #define WSTEP(C0_,C1_,N0_,N1_,T_) do{ \
    _Pragma("unroll") \
    for(int r=0;r<16;++r)C1_[r]+=s32; \
    { const int jb_=T_-(NT0-4); if(jb_>=0)cmask(C0_,C1_,jb_,qrel,hi); } \
    if(T_+2<tb){ asm volatile("s_waitcnt vmcnt(3) lgkmcnt(0)\n\ts_barrier":::"memory"); } else { asm volatile("s_waitcnt vmcnt(0) lgkmcnt(0)\n\ts_barrier":::"memory"); } \
    if(T_+3<tb){XDMA(T_+3,(sl+3)&3);} \
    if(T_+1<tb){ \
      const char*kb=shm+X_LDS_K+((sl+1)&3)*SLOTB+hi*1024+r32*16; \
      bf16x8 k0=*reinterpret_cast<const bf16x8*>(kb), k1=*reinterpret_cast<const bf16x8*>(kb+512); \
      _Pragma("unroll") \
      for(int d0=0;d0<4;++d0){ \
        bf16x8 n0=k0,n1=k1; if(d0<3){ n0=*reinterpret_cast<const bf16x8*>(kb+(d0+1)*2048); n1=*reinterpret_cast<const bf16x8*>(kb+(d0+1)*2048+512); } \
        if(d0==0)N0_=__builtin_amdgcn_mfma_f32_32x32x16_bf16(k0,qr[0],cini,0,0,0); else N0_=__builtin_amdgcn_mfma_f32_32x32x16_bf16(k0,qr[d0],N0_,0,0,0); \
        EX4(C0_,4*d0); SBAR(); \
        if(d0==0)N1_=__builtin_amdgcn_mfma_f32_32x32x16_bf16(k1,qr[0],cini,0,0,0); else N1_=__builtin_amdgcn_mfma_f32_32x32x16_bf16(k1,qr[d0],N1_,0,0,0); \
        EX4(C1_,4*d0); SBAR(); \
        k0=n0;k1=n1; } \
      cini=cini+s64; \
    } else { \
      _Pragma("unroll") \
      for(int d0=0;d0<4;++d0){EX4(C0_,4*d0);EX4(C1_,4*d0);} \
    } \
    const lds_cptr vp_=vp0+sl*X_VSLOT; \
    s16x4 al[8],ah[8]; \
    _Pragma("unroll") \
    for(int i=0;i<8;++i){ al[i]=vtr(vp_+((i>>2)*4096+(i&3)*1024)); ah[i]=vtr(vp_+((i>>2)*4096+(i&3)*1024+512)); } \
    { f32x2_t sa=(f32x2_t){C0_[0],C0_[1]}, sb=(f32x2_t){C1_[0],C1_[1]}; \
      _Pragma("unroll") \
      for(int r=2;r<16;r+=2){ sa+=(f32x2_t){C0_[r],C0_[r+1]}; sb+=(f32x2_t){C1_[r],C1_[r+1]}; } \
      l_reg+=(sa[0]+sa[1])+(sb[0]+sb[1]); } \
    u32x4 pw0,pw1,pw2,pw3; \
    pw0=(u32x4){cvtpk_s(C0_[0],C0_[1]),cvtpk_s(C0_[2],C0_[3]),cvtpk_s(C0_[4],C0_[5]),cvtpk_s(C0_[6],C0_[7])}; pw1=(u32x4){cvtpk_s(C0_[8],C0_[9]),cvtpk_s(C0_[10],C0_[11]),cvtpk_s(C0_[12],C0_[13]),cvtpk_s(C0_[14],C0_[15])}; \
    pw2=(u32x4){cvtpk_s(C1_[0],C1_[1]),cvtpk_s(C1_[2],C1_[3]),cvtpk_s(C1_[4],C1_[5]),cvtpk_s(C1_[6],C1_[7])}; pw3=(u32x4){cvtpk_s(C1_[8],C1_[9]),cvtpk_s(C1_[10],C1_[11]),cvtpk_s(C1_[12],C1_[13]),cvtpk_s(C1_[14],C1_[15])}; \
    const bf16x8 pa0=__builtin_bit_cast(bf16x8,pw0),pa1=__builtin_bit_cast(bf16x8,pw1),pa2=__builtin_bit_cast(bf16x8,pw2),pa3=__builtin_bit_cast(bf16x8,pw3); \
    SBAR(); \
    o[0]=__builtin_amdgcn_mfma_f32_32x32x16_bf16(pa0,VF(al,ah,0),o[0],0,0,0); o[1]=__builtin_amdgcn_mfma_f32_32x32x16_bf16(pa0,VF(al,ah,4),o[1],0,0,0); \
    RELD(0); RELD(4); \
    o[0]=__builtin_amdgcn_mfma_f32_32x32x16_bf16(pa1,VF(al,ah,1),o[0],0,0,0); o[1]=__builtin_amdgcn_mfma_f32_32x32x16_bf16(pa1,VF(al,ah,5),o[1],0,0,0); \
    RELD(1); RELD(5); \
    o[0]=__builtin_amdgcn_mfma_f32_32x32x16_bf16(pa2,VF(al,ah,2),o[0],0,0,0); o[1]=__builtin_amdgcn_mfma_f32_32x32x16_bf16(pa2,VF(al,ah,6),o[1],0,0,0); \
    RELD(2); RELD(6); \
    o[0]=__builtin_amdgcn_mfma_f32_32x32x16_bf16(pa3,VF(al,ah,3),o[0],0,0,0); o[1]=__builtin_amdgcn_mfma_f32_32x32x16_bf16(pa3,VF(al,ah,7),o[1],0,0,0); \
    RELD(3); RELD(7); \
    o[2]=__builtin_amdgcn_mfma_f32_32x32x16_bf16(pa0,VF(al,ah,0),o[2],0,0,0); o[3]=__builtin_amdgcn_mfma_f32_32x32x16_bf16(pa0,VF(al,ah,4),o[3],0,0,0); \
    o[2]=__builtin_amdgcn_mfma_f32_32x32x16_bf16(pa1,VF(al,ah,1),o[2],0,0,0); o[3]=__builtin_amdgcn_mfma_f32_32x32x16_bf16(pa1,VF(al,ah,5),o[3],0,0,0); \
    o[2]=__builtin_amdgcn_mfma_f32_32x32x16_bf16(pa2,VF(al,ah,2),o[2],0,0,0); o[3]=__builtin_amdgcn_mfma_f32_32x32x16_bf16(pa2,VF(al,ah,6),o[3],0,0,0); \
    o[2]=__builtin_amdgcn_mfma_f32_32x32x16_bf16(pa3,VF(al,ah,3),o[2],0,0,0); o[3]=__builtin_amdgcn_mfma_f32_32x32x16_bf16(pa3,VF(al,ah,7),o[3],0,0,0); \
    sl=(sl+1)&3; \
  }while(0)
  f32x16 pD0,pD1;
  for(int t=ta;t<tb;t+=2){ WSTEP(pC0,pC1,pD0,pD1,t); WSTEP(pD0,pD1,pC0,pC1,t+1); }
  #undef WSTEP
  #undef RELD
  {auto rr=__builtin_amdgcn_permlane32_swap(__float_as_uint(l_reg),__float_as_uint(l_reg),false,false);l_reg=__uint_as_float(rr[0])+__uint_as_float(rr[1]);}
  { int r32e=r32; asm volatile("":"+v"(r32e)); if(hi==0)Lw[r32e*8]=l_reg; }
  asm volatile("s_waitcnt lgkmcnt(0)\n\ts_barrier":::"memory");
  bf16*stg=(bf16*)(shm+X_LDS_K)+wid*2048;
  #pragma unroll
  for(int hf=0;hf<2;++hf){
    #pragma unroll
    for(int r=0;r<16;++r){const int orow=crow(r,hi);
      #pragma unroll
      for(int d0=0;d0<2;++d0)stg[orow*64+d0*32+r32]=__float2bfloat16(o[hf*2+d0][r]);}
    asm volatile("s_waitcnt lgkmcnt(0)":::"memory");
    #pragma unroll
    for(int i=0;i<4;++i){const int row=i*8+(lane>>3),ch=lane&7; const u32x4 v=*(const u32x4*)(stg+row*64+ch*8); *(u32x4*)(Ow+(long)row*PO+hf*64+ch*8)=v;}
    asm volatile("s_waitcnt lgkmcnt(0)":::"memory");
  }
  asm volatile("s_waitcnt lgkmcnt(0)\n\ts_barrier":::"memory");
  #undef XDMA
  #undef EX4
  #undef VF
}
constexpr int ATTN_LDS_BYTES=LDS_BYTES;
struct AttnTensors { const bf16* Q; const bf16* K; const bf16* V; bf16* O; float smax2; };
struct AttnUnit { int bh; int qb; };
struct StaticOrder {
  int vcu;
  __device__ __forceinline__ explicit StaticOrder(int grid,int block):vcu((block%8)*(grid/8)+block/8){}
  __device__ __forceinline__ bool next(int i,AttnUnit&u)const{ if(i>=4)return false; const int s=vcu&7; u.bh=vcu>>3; u.qb=(i==0)?s:(i==1)?15-s:(i==2)?16+s:31-s; return true; }
  __device__ __forceinline__ void a_ready(const AttnUnit&)const{}
  __device__ __forceinline__ void done(const AttnUnit&)const{}
};
template<class Sched,int THRL=8> __device__ __forceinline__ void attn_phase(char*lds,const AttnTensors&T,const Sched&S){
  AttnUnit u;
  for(int i=0;S.next(i,u);++i){ S.a_ready(u); attn_unit<THRL>(u.bh/NHEAD,u.bh%NHEAD,u.qb,T.Q,T.K,T.V,T.O,lds,T.smax2,false); S.done(u); }
}
#undef SBAR
#undef WAIT_BAR
}
namespace cg = cooperative_groups;
constexpr int NWAVES = 8;
constexpr int M = 16384, D = 1024, FF = 4096, NIN = 4096, SEQ = 8192;
constexpr float EPS = 1e-6f, ONE_MINUS_LINIT = 0.8f, LAMBDA_INIT = 0.2f;
#ifndef MK_N_LAUNCHES
#define MK_N_LAUNCHES 1
#endif
constexpr int N_PHASES = 8;
constexpr size_t MiB = 1u << 20;
constexpr size_t WS_BAR = 4096, WS_CTL_BYTES = 32768;
constexpr size_t WS_CTR = 0;
constexpr size_t WS_WIN = 2 * MiB, WS_WA = 10 * MiB, WS_WB = 11 * MiB, WS_WOUT = 12 * MiB, WS_W1 = 14 * MiB, WS_W2 = 22 * MiB;
constexpr size_t WS_SSQ = 30 * MiB;
constexpr size_t WS_L0 = 31 * MiB, WS_L1 = 31 * MiB + 512 * 1024;
constexpr size_t WS_P1 = 160 * MiB;
constexpr size_t WS_XN = 32 * MiB;
constexpr size_t WS_OV = 32 * MiB;
constexpr size_t WS_MG = 32 * MiB;
constexpr size_t WS_G = 64 * MiB;
constexpr size_t WS_PL = 128 * MiB, WS_ON = 144 * MiB;
constexpr size_t WS_H = 32 * MiB;
constexpr size_t WS_X1B = 160 * MiB;
constexpr size_t WS_Q = 192 * MiB, WS_K = 208 * MiB, WS_V = 224 * MiB, WS_U = 240 * MiB;
constexpr size_t WS_T1 = 192 * MiB;
constexpr size_t WS_END = 256 * MiB;
constexpr int RING_BYTES = 131072, LDS_BYTES = 147456;

#define GAS __attribute__((address_space(1)))
#define LAS __attribute__((address_space(3)))
typedef unsigned short bf16;
typedef unsigned v4u __attribute__((ext_vector_type(4)));
typedef float f32x4 __attribute__((ext_vector_type(4)));
#define LDS_WAIT() asm volatile("s_waitcnt lgkmcnt(0)" ::: "memory")
#define VM_WAIT() asm volatile("s_waitcnt vmcnt(0)" ::: "memory")
__device__ __forceinline__ unsigned f2bf(float f) { unsigned u = __builtin_bit_cast(unsigned, f); return (u + 0x7fffu + ((u >> 16) & 1u)) >> 16; }
__device__ __forceinline__ unsigned pk2(float lo, float hi) { return f2bf(lo) | (f2bf(hi) << 16); }
__device__ __forceinline__ float bflo(unsigned w) { return __uint_as_float(w << 16); }
__device__ __forceinline__ float bfhi(unsigned w) { return __uint_as_float(w & 0xffff0000u); }
__device__ __forceinline__ float wave_sum(float v) {
#pragma unroll
    for (int o = 1; o < 64; o <<= 1) v += __shfl_xor(v, o);
    return v;
}
__device__ __forceinline__ void p0_transpose_item(const float* W, int K, int N, bf16* WT, int ldw, bool permn, const float* rs, int rsmask, float rsmul, LAS float* scr, int item, int lane) {
    const int nblk = N / 32, kb = item / nblk, nb = item % nblk, k0 = 64 * kb, n0 = 32 * nb;
    float wv[32];
#pragma unroll
    for (int i = 0; i < 32; ++i) { const int kk = 2 * i + (lane >> 5); wv[i] = __builtin_nontemporal_load(&W[(size_t)(k0 + kk) * N + n0 + (lane & 31)]); }
    if (rs) {
#pragma unroll
        for (int i = 0; i < 32; ++i) { const int kk = 2 * i + (lane >> 5); wv[i] *= rs[(k0 + kk) & rsmask] * rsmul; } }
#pragma unroll
    for (int i = 0; i < 32; ++i) { const int kk = 2 * i + (lane >> 5); scr[kk * 33 + (lane & 31)] = wv[i]; }
    LDS_WAIT(); asm volatile("" ::: "memory");
    int n0p = n0; if (permn) { const int ga = (n0 >> 5) & 7; n0p = (n0 & ~255) + 32 * (((ga & 1) << 2) | (ga >> 1)); }
    const int c = lane & 7;
#pragma unroll
    for (int j = 0; j < 4; ++j) { const int n = (lane >> 3) + 8 * j; const LAS float* s = scr + (8 * c) * 33 + n;
        v4u o; o.x = pk2(s[0 * 33], s[1 * 33]); o.y = pk2(s[2 * 33], s[3 * 33]); o.z = pk2(s[4 * 33], s[5 * 33]); o.w = pk2(s[6 * 33], s[7 * 33]);
        *(GAS v4u*)(WT + (size_t)(n0p + n) * ldw + k0 + 8 * c) = o; }
    LDS_WAIT(); asm volatile("" ::: "memory");
}
__device__ __forceinline__ void p0_transpose_item_rt(const float* W, int K, int lgnb, bf16* WT, int ldw, bool has_rs, const float* rs, int rsmask, float rsmul, LAS float* scr, int item, int lane) {
    const int N = 32 << lgnb, kb = item >> lgnb, nb = item & ((1 << lgnb) - 1), k0 = 64 * kb, n0 = 32 * nb;
    float wv[32];
#pragma unroll
    for (int i = 0; i < 32; ++i) { const int kk = 2 * i + (lane >> 5); wv[i] = __builtin_nontemporal_load(&W[(size_t)(k0 + kk) * N + n0 + (lane & 31)]); }
    if (has_rs) {
#pragma unroll
        for (int i = 0; i < 32; ++i) { const int kk = 2 * i + (lane >> 5); wv[i] *= rs[(k0 + kk) & rsmask] * rsmul; } }
#pragma unroll
    for (int i = 0; i < 32; ++i) { const int kk = 2 * i + (lane >> 5); scr[kk * 33 + (lane & 31)] = wv[i]; }
    LDS_WAIT(); asm volatile("" ::: "memory");
    const int c = lane & 7;
#pragma unroll
    for (int j = 0; j < 4; ++j) { const int n = (lane >> 3) + 8 * j; const LAS float* s = scr + (8 * c) * 33 + n;
        v4u o; o.x = pk2(s[0 * 33], s[1 * 33]); o.y = pk2(s[2 * 33], s[3 * 33]); o.z = pk2(s[4 * 33], s[5 * 33]); o.w = pk2(s[6 * 33], s[7 * 33]);
        *(GAS v4u*)(WT + (size_t)(n0 + n) * ldw + k0 + 8 * c) = o; }
    LDS_WAIT(); asm volatile("" ::: "memory");
}
__device__ __forceinline__ void p0_fold_a_wg(const float* pool_w, const float* pool_scale, const float* wba, bf16* WAt, int item, LAS unsigned char* ldsp, int wave, int lane) {
    const int g = item >> 6, n0 = (item & 63) * 16;
    LAS float* wbs = (LAS float*)ldsp; LAS float* pws = (LAS float*)(ldsp + 8192);
    { float v[4];
#pragma unroll
      for (int i = 0; i < 4; ++i) { const int d = wave * 16 + i * 4 + (lane >> 4); v[i] = pool_scale[g * 128 + d] * wba[(size_t)(g * 128 + d) * 1024 + n0 + (lane & 15)]; }
      f32x4 p[8];
#pragma unroll
      for (int i = 0; i < 8; ++i) p[i] = *(const f32x4*)(pool_w + (size_t)g * 16384 + (size_t)wave * 2048 + i * 256 + lane * 4);
#pragma unroll
      for (int i = 0; i < 4; ++i) wbs[(wave * 16 + i * 4 + (lane >> 4)) * 16 + (lane & 15)] = v[i];
#pragma unroll
      for (int i = 0; i < 8; ++i) *(LAS f32x4*)(pws + wave * 2048 + i * 256 + lane * 4) = p[i]; }
    LDS_WAIT(); __syncthreads();
    { const int c0 = wave * 16 + (lane >> 4) * 4, n = lane & 15;
      float o[4] = {0.f, 0.f, 0.f, 0.f};
#pragma unroll 4
      for (int d = 0; d < 128; d += 4) {
          float w[4];
#pragma unroll
          for (int e = 0; e < 4; ++e) w[e] = wbs[(d + e) * 16 + n];
#pragma unroll
          for (int j = 0; j < 4; ++j) { const f32x4 p = *(const LAS f32x4*)(pws + (c0 + j) * 128 + d); o[j] += (p[0] * w[0] + p[1] * w[1]) + (p[2] * w[2] + p[3] * w[3]); }
      }
      *(GAS unsigned long long*)(WAt + (size_t)(n0 + n) * 1024 + g * 128 + c0) = (unsigned long long)pk2(o[0], o[1]) | ((unsigned long long)pk2(o[2], o[3]) << 32); }
    LDS_WAIT(); __syncthreads();
}
template <int R> __device__ __forceinline__ void rms_rows_to_bf16(const float* x, const float* g, bf16* o, int m0, int stride, int lane) {
    f32x4 v[R][4]; float s[R];
#pragma unroll
    for (int i = 0; i < R; ++i) { const GAS f32x4* xr = (const GAS f32x4*)(x + (size_t)(m0 + i * stride) * D) + lane;
#pragma unroll
        for (int j = 0; j < 4; ++j) v[i][j] = __builtin_nontemporal_load(&xr[64 * j]); }
    f32x4 gg[4];
#pragma unroll
    for (int j = 0; j < 4; ++j) gg[j] = ((const GAS f32x4*)g + lane)[64 * j];
#pragma unroll
    for (int i = 0; i < R; ++i) { s[i] = 0.f;
#pragma unroll
        for (int j = 0; j < 4; ++j) s[i] += (v[i][j].x * v[i][j].x + v[i][j].y * v[i][j].y) + (v[i][j].z * v[i][j].z + v[i][j].w * v[i][j].w); }
#pragma unroll
    for (int of = 1; of < 64; of <<= 1) {
#pragma unroll
        for (int i = 0; i < R; ++i) s[i] += __shfl_xor(s[i], of); }
#pragma unroll
    for (int i = 0; i < R; ++i) { const float r = 1.0f / sqrtf(s[i] * (1.0f / D) + EPS);
        GAS unsigned long long* o8 = (GAS unsigned long long*)(o + (size_t)(m0 + i * stride) * D) + lane;
#pragma unroll
        for (int j = 0; j < 4; ++j) o8[64 * j] = (unsigned long long)pk2(v[i][j].x * r * gg[j].x, v[i][j].y * r * gg[j].y) | ((unsigned long long)pk2(v[i][j].z * r * gg[j].z, v[i][j].w * r * gg[j].w) << 32); }
}
__device__ __forceinline__ void pool_row(const bf16* U, bf16* PL, int m, int lane) {
    const int t = m & (SEQ - 1), w = 2 << (lane >> 4), cnt = (t + 1 < w) ? (t + 1) : w;
    const GAS v4u* up = (const GAS v4u*)(U + (size_t)m * 512) + lane;
    float s[8], x0[8];
    { const v4u q = up[0]; x0[0] = bflo(q.x); x0[1] = bfhi(q.x); x0[2] = bflo(q.y); x0[3] = bfhi(q.y); x0[4] = bflo(q.z); x0[5] = bfhi(q.z); x0[6] = bflo(q.w); x0[7] = bfhi(q.w); }
#pragma unroll
    for (int e = 0; e < 8; ++e) s[e] = x0[e];
    v4u qv[15];
#pragma unroll
    for (int i = 1; i < 16; ++i) qv[i - 1] = up[(i < cnt) ? -64 * i : 0];
#pragma unroll
    for (int i = 1; i < 16; ++i) { const v4u q = qv[i - 1]; const float mk = (i < cnt) ? 1.0f : 0.0f;
        s[0] += mk * bflo(q.x); s[1] += mk * bfhi(q.x); s[2] += mk * bflo(q.y); s[3] += mk * bfhi(q.y); s[4] += mk * bflo(q.z); s[5] += mk * bfhi(q.z); s[6] += mk * bflo(q.w); s[7] += mk * bfhi(q.w); }
    const float ic = 1.0f / (float)cnt;
    v4u o; o.x = pk2(s[0] * ic - x0[0], s[1] * ic - x0[1]); o.y = pk2(s[2] * ic - x0[2], s[3] * ic - x0[3]); o.z = pk2(s[4] * ic - x0[4], s[5] * ic - x0[5]); o.w = pk2(s[6] * ic - x0[6], s[7] * ic - x0[7]);
    *((GAS v4u*)(PL + (size_t)m * 1024) + lane) = o;
}
__device__ __forceinline__ void combine_row(const bf16* OV, bf16* ON, int m, float lam, int lane) {
    const int h = lane >> 4, j8 = (lane & 15) * 8;
    const v4u a = *(const GAS v4u*)(OV + (size_t)m * 1024 + h * 256 + j8), b = *(const GAS v4u*)(OV + (size_t)m * 1024 + h * 256 + 128 + j8);
    float d[8];
    d[0] = bflo(a.x) - lam * bflo(b.x); d[1] = bfhi(a.x) - lam * bfhi(b.x); d[2] = bflo(a.y) - lam * bflo(b.y); d[3] = bfhi(a.y) - lam * bfhi(b.y);
    d[4] = bflo(a.z) - lam * bflo(b.z); d[5] = bfhi(a.z) - lam * bfhi(b.z); d[6] = bflo(a.w) - lam * bflo(b.w); d[7] = bfhi(a.w) - lam * bfhi(b.w);
    float ss = 0.f;
#pragma unroll
    for (int e = 0; e < 8; ++e) ss += d[e] * d[e];
    ss += __shfl_xor(ss, 1); ss += __shfl_xor(ss, 2); ss += __shfl_xor(ss, 4); ss += __shfl_xor(ss, 8);
    const float r = 1.0f / sqrtf(ss * (1.0f / 128.0f) + EPS);
    v4u o; o.x = pk2(d[0] * r, d[1] * r); o.y = pk2(d[2] * r, d[3] * r); o.z = pk2(d[4] * r, d[5] * r); o.w = pk2(d[6] * r, d[7] * r);
    *(GAS v4u*)(ON + (size_t)m * 1024 + 512 + h * 128 + j8) = o;
}
template <int R> __device__ __forceinline__ void combine_wide(const bf16* P0, const bf16* P1, const float* L0, const float* L1, bf16* ON, int m0, int stride, float lam, float smax2, int lane) {
    const int h = lane >> 4, j8 = (lane & 15) * 8;
    v4u a0[R], a1[R], b0[R], b1[R]; float la[R], lb[R];
#pragma unroll
    for (int i = 0; i < R; ++i) { const size_t m = (size_t)(m0 + i * stride), o = m * 1024 + h * 256 + j8;
        const bool cut = attn_body::wide_cut((int)(m & (SEQ - 1)) & ~255, h, smax2);
        a0[i] = *(const GAS v4u*)(P0 + o); b0[i] = *(const GAS v4u*)(P0 + o + 128); la[i] = L0[m * 8 + h * 2]; lb[i] = L0[m * 8 + h * 2 + 1];
        a1[i] = (v4u){0u, 0u, 0u, 0u}; b1[i] = a1[i];
        if (cut) { a1[i] = *(const GAS v4u*)(P1 + o); b1[i] = *(const GAS v4u*)(P1 + o + 128); la[i] += L1[m * 8 + h * 2]; lb[i] += L1[m * 8 + h * 2 + 1]; } }
#pragma unroll
    for (int i = 0; i < R; ++i) {
        const float ia = 1.0f / la[i], ib = lam / lb[i];
        float d[8];
        d[0] = (bflo(a0[i].x) + bflo(a1[i].x)) * ia - (bflo(b0[i].x) + bflo(b1[i].x)) * ib; d[1] = (bfhi(a0[i].x) + bfhi(a1[i].x)) * ia - (bfhi(b0[i].x) + bfhi(b1[i].x)) * ib;
        d[2] = (bflo(a0[i].y) + bflo(a1[i].y)) * ia - (bflo(b0[i].y) + bflo(b1[i].y)) * ib; d[3] = (bfhi(a0[i].y) + bfhi(a1[i].y)) * ia - (bfhi(b0[i].y) + bfhi(b1[i].y)) * ib;
        d[4] = (bflo(a0[i].z) + bflo(a1[i].z)) * ia - (bflo(b0[i].z) + bflo(b1[i].z)) * ib; d[5] = (bfhi(a0[i].z) + bfhi(a1[i].z)) * ia - (bfhi(b0[i].z) + bfhi(b1[i].z)) * ib;
        d[6] = (bflo(a0[i].w) + bflo(a1[i].w)) * ia - (bflo(b0[i].w) + bflo(b1[i].w)) * ib; d[7] = (bfhi(a0[i].w) + bfhi(a1[i].w)) * ia - (bfhi(b0[i].w) + bfhi(b1[i].w)) * ib;
        float ss = 0.f;
#pragma unroll
        for (int e = 0; e < 8; ++e) ss += d[e] * d[e];
        ss += __shfl_xor(ss, 1); ss += __shfl_xor(ss, 2); ss += __shfl_xor(ss, 4); ss += __shfl_xor(ss, 8);
        const float r = 1.0f / sqrtf(ss * (1.0f / 128.0f) + EPS);
        v4u o; o.x = pk2(d[0] * r, d[1] * r); o.y = pk2(d[2] * r, d[3] * r); o.z = pk2(d[4] * r, d[5] * r); o.w = pk2(d[6] * r, d[7] * r);
        *(GAS v4u*)(ON + (size_t)(m0 + i * stride) * 1024 + 512 + h * 128 + j8) = o; }
}
#define XB_TMO      128
#define XB_XCNT(j)  (256  + 64 * (j))
#define XB_XSUB(j)  (1280 + 64 * (j))
#define XB_XGEN(j)  (2304 + 64 * (j))
#define XB_TOP      3328
#define XB_TOPGEN   3392
#define XCD_BAR_WORDS 3456
#define XB_SPIN_CAP (1u << 18)

__device__ __forceinline__ unsigned xb_ld(unsigned* p)              { return __hip_atomic_load(p, __ATOMIC_RELAXED, __HIP_MEMORY_SCOPE_AGENT); }
__device__ __forceinline__ unsigned xb_add(unsigned* p, unsigned v) { return __hip_atomic_fetch_add(p, v, __ATOMIC_RELAXED, __HIP_MEMORY_SCOPE_AGENT); }
__device__ __forceinline__ unsigned xb_xcc_id() { return (unsigned)__builtin_amdgcn_s_getreg((3 << 11) | 20) & 0xFu; }
#define XB_SPIN(cond, bar) do { unsigned _sp = 0; while (cond) { __builtin_amdgcn_s_sleep(1); \
    if ((++_sp & 255u) == 0u) { if (xb_ld(&(bar)[XB_TMO])) break; if (_sp > XB_SPIN_CAP) { atomicAdd(&(bar)[XB_TMO], 1u); break; } } } } while (0)

struct XcdBarrier {
    unsigned* bar; unsigned x;
    volatile LAS unsigned* st;
};

__device__ __forceinline__ XcdBarrier xcd_barrier_post(unsigned* bar, volatile LAS unsigned* st) {
    XcdBarrier b; b.bar = bar; b.x = xb_xcc_id(); b.st = st;
    if (threadIdx.x == 0) (void)xb_add(&bar[XB_XCNT(b.x)], 1u);
    return b;
}
__device__ __forceinline__ void xcd_barrier_complete(unsigned* bar, unsigned x, unsigned& nloc, unsigned& nx) {
    const unsigned G = gridDim.x * gridDim.y * gridDim.z;
    unsigned sum, cnt, mine, sp = 0u;
    for (;;) {
        sum = 0u; cnt = 0u; mine = 0u;
#pragma unroll
        for (unsigned j = 0; j < 16; ++j) { const unsigned c = xb_ld(&bar[XB_XCNT(j)]); sum += c; cnt += (c > 0u) ? 1u : 0u; mine = (j == x) ? c : mine; }
        if (sum == G) break;
        __builtin_amdgcn_s_sleep(1);
        if ((++sp & 255u) == 0u) { if (xb_ld(&bar[XB_TMO])) break; if (sp > XB_SPIN_CAP) { atomicAdd(&bar[XB_TMO], 1u); break; } }
    }
    nloc = mine > 0u ? mine : 1u; nx = cnt > 0u ? cnt : 1u;
}

__device__ __forceinline__ void xcd_barrier(const XcdBarrier& b) {
    asm volatile("s_waitcnt vmcnt(0)" ::: "memory");
    __syncthreads();
    if (threadIdx.x == 0) {
        unsigned* bar = b.bar;
        __builtin_amdgcn_s_waitcnt(0);
        unsigned nloc = b.st[0], nx = b.st[1];
        if (nloc == 0u) { xcd_barrier_complete(bar, b.x, nloc, nx); b.st[0] = nloc; b.st[1] = nx; }
        const unsigned old = xb_add(&bar[XB_XSUB(b.x)], 1u);
        const unsigned gen = old / nloc;
        if (old + 1u == (gen + 1u) * nloc) {
            __builtin_amdgcn_fence(__ATOMIC_RELEASE, "agent");
            asm volatile("s_waitcnt vmcnt(0)" ::: "memory");
            const unsigned og = xb_add(&bar[XB_TOP], 1u);
            const unsigned tg = og / nx;
            if (og + 1u == (tg + 1u) * nx) xb_add(&bar[XB_TOPGEN], 1u);
            else XB_SPIN(xb_ld(&bar[XB_TOPGEN]) == tg, bar);
            __builtin_amdgcn_fence(__ATOMIC_ACQUIRE, "agent");
            xb_add(&bar[XB_XGEN(b.x)], 1u);
            asm volatile("s_waitcnt vmcnt(0)" ::: "memory");
        } else {
            XB_SPIN(xb_ld(&bar[XB_XGEN(b.x)]) == gen, bar);
            __builtin_amdgcn_fence(__ATOMIC_ACQUIRE, "agent");
            asm volatile("s_waitcnt vmcnt(0)" ::: "memory");
        }
    }
    __syncthreads();
}

struct StrideOrder {
    int G, b;
    __device__ __forceinline__ bool next(int i, attn_body::AttnUnit& u) const { const int idx = b + i * G; if (idx >= 1024) return false; u.bh = idx >> 5; u.qb = 31 - (idx & 31); return true; }
    __device__ __forceinline__ void a_ready(const attn_body::AttnUnit&) const {}
    __device__ __forceinline__ void done(const attn_body::AttnUnit&) const {}
};

struct Args { const float* in[19]; float* out; unsigned char* ws; int ph_lo, ph_hi; };
__global__ void __launch_bounds__(NWAVES * 64, 2) fwd_kernel(Args args) {
    extern __shared__ __attribute__((aligned(16))) unsigned char lds[];
    __builtin_assume(__builtin_amdgcn_workitem_id_y() == 0); __builtin_assume(__builtin_amdgcn_workitem_id_z() == 0);
    LAS unsigned char* ldsp = (LAS unsigned char*)lds;
    const int tid = threadIdx.x, lane = tid & 63, wave = __builtin_amdgcn_readfirstlane(tid >> 6);
    const int G = gridDim.x, bx = blockIdx.x;
    const int vcu = (G % 8 == 0) ? (bx % 8) * (G / 8) + bx / 8 : bx;
    const int gw = vcu * NWAVES + wave, NGW = G * NWAVES;
    const int lo = args.ph_lo, hi = args.ph_hi;
    if (lo < 0) cg::this_grid().sync();
    volatile LAS unsigned* bst = (volatile LAS unsigned*)(ldsp + RING_BYTES + 32);
    if (tid == 0) { bst[0] = 0u; bst[1] = 0u; }
    __syncthreads();
    { const __attribute__((address_space(4))) Args* ap0 = (const __attribute__((address_space(4))) Args*)__builtin_amdgcn_kernarg_segment_ptr(); (void)xcd_barrier_post((unsigned*)(ap0->ws + WS_BAR), bst); }
#ifndef PHASE_MASK
#define PHASE_MASK 0xFF
#endif
#define IN(k) (((PHASE_MASK >> (k)) & 1) && lo <= (k) && (k) < hi)
#define SEAM(k) do { if (IN(k) && IN((k) + 1)) { ARGS_RELOAD(); XcdBarrier xb_; xb_.bar = WSP(unsigned, WS_BAR); xb_.x = xb_xcc_id(); xb_.st = bst; xcd_barrier(xb_); } } while (0)
#define ARGS_RELOAD() const __attribute__((address_space(4))) Args* ap = (const __attribute__((address_space(4))) Args*)__builtin_amdgcn_kernarg_segment_ptr(); asm volatile("" : "+s"(ap)); unsigned char* const ws = ap->ws
#define WSP(T, off) ((T*)(ws + (off)))

    if (IN(0)) {
        ARGS_RELOAD();
        LAS float* scr = (LAS float*)(ldsp + wave * 16384);
        constexpr int I_IN = (D / 64) * (NIN / 32);
        for (int it = vcu; it < 256; it += G) p0_fold_a_wg(ap->in[4], ap->in[5], ap->in[13], WSP(bf16, WS_WA), it, ldsp, wave, lane);
        for (int it = gw; it < I_IN; it += NGW) p0_transpose_item(ap->in[2], D, NIN, WSP(bf16, WS_WIN), D, true, nullptr, 0, 1.f, scr, it, lane);
#ifdef PROBE_RMS2
        for (int rep_ = 0; rep_ < 2; ++rep_)
#endif
        for (int m = gw; m + 3 * NGW < M; m += 4 * NGW) rms_rows_to_bf16<4>(ap->in[0], ap->in[1], WSP(bf16, WS_XN), m, NGW, lane);
        for (int m = gw + (M / (4 * NGW)) * 4 * NGW; m < M; m += NGW) rms_rows_to_bf16<1>(ap->in[0], ap->in[1], WSP(bf16, WS_XN), m, NGW, lane);
        VM_WAIT(); __syncthreads();
    }
    SEAM(0);
#ifdef PROBE_SYNC8
    for (int rep_ = 0; rep_ < 8; ++rep_) { ARGS_RELOAD(); XcdBarrier xb_; xb_.bar = WSP(unsigned, WS_BAR); xb_.x = xb_xcc_id(); xb_.st = bst; xcd_barrier(xb_); }
#endif
    if (IN(1)) {
        ARGS_RELOAD();
        pg8::Gemm g{WSP(bf16, WS_XN), WSP(bf16, WS_WIN), M, NIN, D}; pg8::StaticOrder S; S.init(M, NIN, G, bx);
        pg8::EpiIn E{WSP(bf16, WS_U), WSP(bf16, WS_Q), WSP(bf16, WS_K), WSP(bf16, WS_V), WSP(bf16, WS_G), ap->in[6], ap->in[7], ap->in[3]};
        pg8::gemm_phase<pg8::EpiIn, pg8::StaticOrder, true, true>(ldsp, g, S, E);
    }
    SEAM(1);
    if (IN(2)) {
        ARGS_RELOAD();
#ifdef PROBE_POOL2
        for (int rep_ = 0; rep_ < 2; ++rep_)
#endif
        for (int m = gw; m < M; m += NGW) pool_row(WSP(bf16, WS_U), WSP(bf16, WS_PL), m, lane);
        VM_WAIT(); __syncthreads();
        float gq = __builtin_fabsf(ap->in[6][lane]), gk = __builtin_fabsf(ap->in[7][lane]);
#pragma unroll
        for (int o = 1; o < 64; o <<= 1) { gq = __builtin_fmaxf(gq, __shfl_xor(gq, o)); gk = __builtin_fmaxf(gk, __shfl_xor(gk, o)); }
        const float smax2 = pg8::QK_C2 * 64.0f * gq * gk * 1.05f + 1.0f;
        const attn_body::bf16 *Qp = WSP(const attn_body::bf16, WS_Q), *Kp = WSP(const attn_body::bf16, WS_K), *Vp = WSP(const attn_body::bf16, WS_V); attn_body::bf16* Op = WSP(attn_body::bf16, WS_OV);
        unsigned* ctr = WSP(unsigned, WS_CTR);
        const bool nomax = __builtin_amdgcn_readfirstlane(smax2 < 60.0f ? 1 : 0) != 0;
        volatile LAS unsigned* qs = (volatile LAS unsigned*)(ldsp + RING_BYTES + 64);
        int idx2 = 0;
        for (;;) {
            if (tid == 0) *qs = atomicAdd(ctr, 1u);
            __syncthreads();
            const int idx = __builtin_amdgcn_readfirstlane((int)*qs);
            __syncthreads();
            if (idx >= 1024) { idx2 = idx; break; }
            if (nomax) {
                int b_, hc_, qb_, sp_;
                if (idx < 256) { const int r = idx & 15; qb_ = 31 - (idx >> 4); b_ = r >> 3; hc_ = 4 + ((r >> 1) & 3); sp_ = r & 1; }
                else { int j = idx - 256; sp_ = 0; if (j >= 384) { j -= 384; sp_ = 1; }
                    if (j < 128) { const int r = j & 7; qb_ = 15 - (j >> 3); b_ = r >> 2; hc_ = 4 + (r & 3); }
                    else if (j < 256) { j -= 128; const int r = j & 3; qb_ = 31 - (j >> 2); b_ = r >> 1; hc_ = 2 + (r & 1); }
                    else { j -= 256; const int r = j & 3; qb_ = 31 - (j >> 2); b_ = r >> 1; hc_ = r & 1; } }
                attn_body::attn_wide2(b_, hc_, qb_, sp_, Qp, Kp, Vp, Op, WSP(attn_body::bf16, WS_P1), WSP(float, WS_L0), WSP(float, WS_L1), (char*)lds, smax2); }
            else attn_body::attn_unit<8>((idx >> 4) & 1, idx & 15, 31 - (idx >> 5), Qp, Kp, Vp, Op, (char*)lds, smax2, false);
        }
        {   ARGS_RELOAD();
            unsigned* ctr2 = WSP(unsigned, WS_CTR);
            int tid2 = threadIdx.x; asm volatile("" : "+v"(tid2));
            const int lane2 = tid2 & 63, wave2 = __builtin_amdgcn_readfirstlane(tid2 >> 6);
            volatile LAS unsigned* qs2 = (volatile LAS unsigned*)(ldsp + RING_BYTES + 64);
            LAS float* scr2 = (LAS float*)(ldsp + wave2 * 16384);
            constexpr int I_OUT = (D / 64) * (D / 32), I_1 = (D / 64) * (FF / 32), I_2 = (FF / 64) * (D / 32), I_B = (512 / 64) * (D / 32), N_TR = (I_OUT + I_1 + I_2 + I_B) / 32;
            static_assert((I_OUT + I_1 + I_2 + I_B) % 32 == 0, "deferred transposes per workgroup item");
            while (idx2 < 1024 + N_TR) {
                for (int k = 0; k < 4; ++k) { int r = (idx2 - 1024) * 32 + wave2 * 4 + k;
                    const float* W; int K_, lg; bf16* WT; int ldw; bool hrs; const float* rs; int rsmask; float rsmul;
                    if (r < I_OUT) { W = ap->in[15]; K_ = D; lg = 5; WT = WSP(bf16, WS_WOUT); ldw = D; hrs = false; rs = W; rsmask = 0; rsmul = 1.f; }
                    else if (r < I_OUT + I_1) { r -= I_OUT; W = ap->in[17]; K_ = D; lg = 7; WT = WSP(bf16, WS_W1); ldw = D; hrs = true; rs = ap->in[16]; rsmask = 1023; rsmul = 1.f; }
                    else if (r < I_OUT + I_1 + I_2) { r -= I_OUT + I_1; W = ap->in[18]; K_ = FF; lg = 5; WT = WSP(bf16, WS_W2); ldw = FF; hrs = false; rs = W; rsmask = 0; rsmul = 1.f; }
                    else { r -= I_OUT + I_1 + I_2; W = ap->in[14]; K_ = 512; lg = 5; WT = WSP(bf16, WS_WA) + 512; ldw = 1024; hrs = true; rs = ap->in[12]; rsmask = 127; rsmul = ONE_MINUS_LINIT; }
                    p0_transpose_item_rt(W, K_, lg, WT, ldw, hrs, rs, rsmask, rsmul, scr2, r, lane2); }
                if (tid2 == 0) *qs2 = atomicAdd(ctr2, 1u);
                __syncthreads();
                idx2 = __builtin_amdgcn_readfirstlane((int)*qs2);
                __syncthreads();
            }
        }
    }
    SEAM(2);
    if (IN(3)) {
        ARGS_RELOAD();
        const float lam = expf(wave_sum(ap->in[8][lane] * ap->in[9][lane])) - expf(wave_sum(ap->in[10][lane] * ap->in[11][lane])) + LAMBDA_INIT;
        float gq = __builtin_fabsf(ap->in[6][lane]), gk = __builtin_fabsf(ap->in[7][lane]);
#pragma unroll
        for (int o = 1; o < 64; o <<= 1) { gq = __builtin_fmaxf(gq, __shfl_xor(gq, o)); gk = __builtin_fmaxf(gk, __shfl_xor(gk, o)); }
        const float smax2c = pg8::QK_C2 * 64.0f * gq * gk * 1.05f + 1.0f;
        const bool nomax = __builtin_amdgcn_readfirstlane(smax2c < 60.0f ? 1 : 0) != 0;
        if (nomax) { int m = gw; for (; m + 3 * NGW < M; m += 4 * NGW) combine_wide<4>(WSP(bf16, WS_OV), WSP(bf16, WS_P1), WSP(float, WS_L0), WSP(float, WS_L1), WSP(bf16, WS_PL), m, NGW, lam, smax2c, lane);
                     for (; m < M; m += NGW) combine_wide<1>(WSP(bf16, WS_OV), WSP(bf16, WS_P1), WSP(float, WS_L0), WSP(float, WS_L1), WSP(bf16, WS_PL), m, NGW, lam, smax2c, lane); }
        else for (int m = gw; m < M; m += NGW) combine_row(WSP(bf16, WS_OV), WSP(bf16, WS_PL), m, lam, lane);
        VM_WAIT(); __syncthreads();
    }
    SEAM(3);
    if (IN(4)) {
        ARGS_RELOAD();
        pg8::Gemm g{WSP(bf16, WS_PL), WSP(bf16, WS_WA), M, D, 1024}; pg8::StaticOrder S; S.init(M, D, G, bx);
        pg8::EpiMerge E{WSP(bf16, WS_G), WSP(bf16, WS_MG)};
        pg8::gemm_phase<pg8::EpiMerge, pg8::StaticOrder, true, true>(ldsp, g, S, E);
    }
    SEAM(4);
    if (IN(5)) {
        ARGS_RELOAD();
        pg8::Gemm g{WSP(bf16, WS_MG), WSP(bf16, WS_WOUT), M, D, D}; pg8::StaticOrder S; S.init(M, D, G, bx);
        pg8::EpiOut E{ap->in[0], WSP(bf16, WS_X1B), WSP(float, WS_SSQ)};
        pg8::gemm_phase<pg8::EpiOut, pg8::StaticOrder, true, true>(ldsp, g, S, E);
    }
    SEAM(5);
    if (IN(6)) {
        ARGS_RELOAD();
        pg8::Gemm g{WSP(bf16, WS_X1B), WSP(bf16, WS_W1), M, FF, D}; pg8::StaticOrder S; S.init(M, FF, G, bx);
        pg8::Unit u0{-1, 0}; (void)S.next(0, u0);
        LAS float* rtab = (LAS float*)(ldsp + RING_BYTES + 1024);
        if (u0.pm >= 0 && tid < 256) { const f32x4* sp = (const f32x4*)(WSP(float, WS_SSQ) + (size_t)(u0.pm * 256 + tid) * 16); const f32x4 s4 = (sp[0] + sp[1]) + (sp[2] + sp[3]);
            rtab[tid] = __builtin_amdgcn_rsqf(((s4[0] + s4[1]) + (s4[2] + s4[3])) * (1.0f / 1024.0f) + 1e-6f); }
        LDS_WAIT(); __syncthreads();
        pg8::EpiFF1 E{WSP(float, WS_SSQ), WSP(bf16, WS_H), u0.pm, rtab};
        pg8::gemm_phase<pg8::EpiFF1, pg8::StaticOrder, true, true>(ldsp, g, S, E);
    }
    SEAM(6);
    if (IN(7)) {
        ARGS_RELOAD();
        pg8::Gemm g{WSP(bf16, WS_H), WSP(bf16, WS_W2), M, D, FF}; pg8::StaticOrder S; S.init(M, D, G, bx);
        pg8::EpiFF2 E{WSP(bf16, WS_X1B), ap->out};
        pg8::gemm_phase<pg8::EpiFF2, pg8::StaticOrder, true, true>(ldsp, g, S, E);
    }
#undef IN
#undef SEAM
#undef ARGS_RELOAD
#undef WSP
}

#ifdef DBG_STOP
__global__ void dbg_dump(const unsigned short* __restrict__ buf, float* __restrict__ out, size_t n) {
    for (size_t i = (size_t)blockIdx.x * blockDim.x + threadIdx.x; i < n; i += (size_t)gridDim.x * blockDim.x) out[i] = __uint_as_float((unsigned)buf[i] << 16);
}
__global__ void dbg_dump32(const float* __restrict__ buf, float* __restrict__ out, size_t n) {
    for (size_t i = (size_t)blockIdx.x * blockDim.x + threadIdx.x; i < n; i += (size_t)gridDim.x * blockDim.x) out[i] = buf[i];
}
#endif
extern "C" void kernel_launch(void* const* d_in, const int* in_sizes, int n_in, void* d_out, int out_size, void* d_ws, size_t ws_size, hipStream_t stream) {
    static int grid = 0;
    if (grid == 0) {
        if (n_in != 19 || out_size != M * D || ws_size < WS_END) { fprintf(stderr, "kernel_launch: unexpected shapes (n_in %d out %d ws %zu)\n", n_in, out_size, ws_size); grid = -1; return; }
        int dev = 0, cus = 0, per_cu = 0;
        hipGetDevice(&dev); hipDeviceGetAttribute(&cus, hipDeviceAttributeMultiprocessorCount, dev);
        if (hipFuncSetAttribute((const void*)fwd_kernel, hipFuncAttributeMaxDynamicSharedMemorySize, LDS_BYTES) != hipSuccess) { fprintf(stderr, "kernel_launch: hipFuncSetAttribute failed\n"); grid = -1; return; }
        if (hipOccupancyMaxActiveBlocksPerMultiprocessor(&per_cu, (const void*)fwd_kernel, NWAVES * 64, LDS_BYTES) != hipSuccess || per_cu < 1) per_cu = 1;
        (void)hipGetLastError();
        grid = cus * per_cu;
    }
    if (grid < 0) return;
    Args a{};
    for (int i = 0; i < 19; ++i) a.in[i] = (const float*)d_in[i];
    a.out = (float*)d_out; a.ws = (unsigned char*)d_ws;
#if MK_N_LAUNCHES == 1
    void* kargs[] = {&a};
    (void)hipMemsetAsync(d_ws, 0, WS_CTL_BYTES, stream);
#ifdef PROBE_DUP
    a.ph_lo = 0; a.ph_hi = PROBE_DUP_HI;
    (void)hipLaunchCooperativeKernel((const void*)fwd_kernel, dim3(grid), dim3(NWAVES * 64), kargs, LDS_BYTES, stream);
    (void)hipMemsetAsync(d_ws, 0, WS_CTL_BYTES, stream);
    a.ph_lo = PROBE_DUP_LO; a.ph_hi = N_PHASES;
#else
    a.ph_lo = 0; a.ph_hi = N_PHASES;
#endif
    hipError_t e = hipLaunchCooperativeKernel((const void*)fwd_kernel, dim3(grid), dim3(NWAVES * 64), kargs, LDS_BYTES, stream);
    if (e != hipSuccess) fprintf(stderr, "kernel_launch: cooperative launch failed: %s (grid %d)\n", hipGetErrorString(e), grid);
#else
#ifdef DBG_STOP
    for (int p = 0; p <= DBG_STOP; ++p) { a.ph_lo = p; a.ph_hi = p + 1; hipLaunchKernelGGL(fwd_kernel, dim3(grid), dim3(NWAVES * 64), LDS_BYTES, stream, a); }
#ifdef DBG_F32
    hipLaunchKernelGGL(dbg_dump32, dim3(2048), dim3(256), 0, stream, (const float*)((unsigned char*)d_ws + DBG_OFF), (float*)d_out, (size_t)M * D);
#else
    hipLaunchKernelGGL(dbg_dump, dim3(2048), dim3(256), 0, stream, (const unsigned short*)((unsigned char*)d_ws + DBG_OFF), (float*)d_out, (size_t)M * D);
#endif
#else
    for (int p = 0; p < N_PHASES; ++p) { a.ph_lo = p; a.ph_hi = p + 1; hipLaunchKernelGGL(fwd_kernel, dim3(grid), dim3(NWAVES * 64), LDS_BYTES, stream, a); }
#endif
#endif
}
```
